# Optimizing an MI355X kernel written in HIP

```python
import math
import jax, jax.numpy as jnp
from jax import lax
import numpy as np

D_MODEL = 1024
BATCH = 16
SEQ = 2048
DEPTH = 1

EPS = 1e-6
D_RNN = 512
RNN_HEADS = 8
RNN_HEAD_DIM = D_RNN // RNN_HEADS
CONV_WIDTH = 4
LRU_C = 8.0
LRU_A_MIN = 0.9
LRU_A_MAX = 0.999
N_Q_HEADS = 8
N_KV_HEADS = 2
HEAD_DIM = 64
Q_PER_KV = N_Q_HEADS // N_KV_HEADS
D_ATTN = N_Q_HEADS * HEAD_DIM
D_KV = N_KV_HEADS * HEAD_DIM
CMP_BLOCK = 32
CMP_STRIDE = 16
CMP_HIDDEN = 256
SEL_BLOCK = 64
SEL_TOPK = 8
SEL_Q_BLOCK = 64
SEL_FORCE = 1e9
WINDOW = 512
WIN_Q_BLOCK = 128
N_BRANCH = 3
D_MIX = D_RNN + D_ATTN
SPLIT_SIZES = (D_RNN, D_RNN, D_ATTN, D_KV, D_KV, D_KV, D_KV, D_KV, D_KV, D_ATTN, N_BRANCH * N_Q_HEADS)
D_IN = 2 * D_RNN + 2 * D_ATTN + 6 * D_KV + N_BRANCH * N_Q_HEADS

kernel_name = "hybrid_rglru_nsa_parallel_heads"


def rms_norm(x, w):
    xf = x.astype(jnp.float32)
    y = xf * lax.rsqrt(jnp.mean(xf * xf, axis=-1, keepdims=True) + EPS)
    return (y * w.astype(jnp.float32)).astype(x.dtype)


def masked_softmax(s, mask):
    s = jnp.where(mask, s, -jnp.inf)
    m = jnp.max(s, axis=-1, keepdims=True)
    m = jnp.where(jnp.isfinite(m), m, 0.0)
    e = jnp.where(mask, jnp.exp(s - m), 0.0)
    den = jnp.sum(e, axis=-1, keepdims=True)
    return e / jnp.where(den > 0, den, 1.0)


def causal_depthwise_conv(x, w, b):
    S = x.shape[1]
    xp = jnp.pad(x, ((0, 0), (CONV_WIDTH - 1, 0), (0, 0)))
    out = b
    for k in range(CONV_WIDTH):
        out = out + xp[:, k:k + S] * w[k]
    return out


def rg_lru(x, wa, ba, wx, bx, lam):
    B, S, _ = x.shape
    xh = x.reshape(B, S, RNN_HEADS, RNN_HEAD_DIM)
    r = jax.nn.sigmoid(jnp.einsum('bshi,hij->bshj', xh, wa).reshape(B, S, D_RNN) + ba)
    i = jax.nn.sigmoid(jnp.einsum('bshi,hij->bshj', xh, wx).reshape(B, S, D_RNN) + bx)
    log_a = LRU_C * r.astype(jnp.float32) * jax.nn.log_sigmoid(lam.astype(jnp.float32))
    a = jnp.exp(log_a)
    u = jnp.sqrt(-jnp.expm1(2.0 * log_a)) * (i * x).astype(jnp.float32)

    def combine(c1, c2):
        a1, b1 = c1
        a2, b2 = c2
        return a1 * a2, a2 * b1 + b2

    _, h = lax.associative_scan(combine, (a, u), axis=1)
    return h.astype(x.dtype)


def compress_blocks(k, pe, w1, w2):
    B, S, G, dh = k.shape
    n_cmp = (S - CMP_BLOCK) // CMP_STRIDE + 1
    idx = jnp.arange(n_cmp)[:, None] * CMP_STRIDE + jnp.arange(CMP_BLOCK)[None, :]
    blocks = k[:, idx] + pe[None, None, :, None, :]
    flat = blocks.transpose(0, 1, 3, 2, 4).reshape(B, n_cmp, G, CMP_BLOCK * dh)
    return jax.nn.silu(flat @ w1) @ w2


def cmp_sel_overlap(n_cmp, n_sel):
    cs = jnp.arange(n_cmp)[:, None] * CMP_STRIDE
    ss = jnp.arange(n_sel)[None, :] * SEL_BLOCK
    ov = jnp.clip(jnp.minimum(cs + CMP_BLOCK, ss + SEL_BLOCK) - jnp.maximum(cs, ss), 0, None)
    return ov.astype(jnp.float32) / CMP_BLOCK


def to_chunks(a, size):
    B, S = a.shape[:2]
    return jnp.moveaxis(a.reshape((B, S // size, size) + a.shape[2:]), 1, 0)


def selected_attention(q, k, v, idx, valid):
    B, S, G, R, dh = q.shape
    n = idx.shape[-1]
    scale = dh ** -0.5
    kb = k.reshape(B, S // SEL_BLOCK, SEL_BLOCK, G, dh).transpose(0, 3, 1, 2, 4)
    vb = v.reshape(B, S // SEL_BLOCK, SEL_BLOCK, G, dh).transpose(0, 3, 1, 2, 4)
    gather = jax.vmap(jax.vmap(lambda blocks, ids: blocks[ids]))

    def chunk(args):
        q_c, idx_c, valid_c, t_c = args
        Tq = q_c.shape[1]
        ids = idx_c.transpose(0, 2, 1, 3)
        kg = gather(kb, ids)
        vg = gather(vb, ids)
        pos = idx_c[..., None] * SEL_BLOCK + jnp.arange(SEL_BLOCK)
        mask = valid_c[..., None] & (pos <= t_c[None, :, None, None, None])
        s = jnp.einsum('btgrd,bgtnld->btgrnl', q_c, kg).astype(jnp.float32) * scale
        s = s.reshape(B, Tq, G, R, n * SEL_BLOCK)
        p = masked_softmax(s, mask.reshape(B, Tq, G, 1, n * SEL_BLOCK)).reshape(B, Tq, G, R, n, SEL_BLOCK)
        return jnp.einsum('btgrnl,bgtnld->btgrd', p.astype(vg.dtype), vg)

    t_chunks = jnp.arange(S).reshape(S // SEL_Q_BLOCK, SEL_Q_BLOCK)
    out = lax.map(chunk, (to_chunks(q, SEL_Q_BLOCK), to_chunks(idx, SEL_Q_BLOCK),
                          to_chunks(valid, SEL_Q_BLOCK), t_chunks))
    return jnp.moveaxis(out, 0, 1).reshape(B, S, G, R, dh)


def window_attention(q, k, v):
    B, S, G, R, dh = q.shape
    scale = dh ** -0.5
    kp = jnp.pad(k, ((0, 0), (WINDOW, 0), (0, 0), (0, 0)))
    vp = jnp.pad(v, ((0, 0), (WINDOW, 0), (0, 0), (0, 0)))
    band = WIN_Q_BLOCK + WINDOW

    def block(i):
        q0 = i * WIN_Q_BLOCK
        qb = lax.dynamic_slice_in_dim(q, q0, WIN_Q_BLOCK, axis=1)
        kb = lax.dynamic_slice_in_dim(kp, q0, band, axis=1)
        vb = lax.dynamic_slice_in_dim(vp, q0, band, axis=1)
        t = q0 + jnp.arange(WIN_Q_BLOCK)
        s_pos = q0 - WINDOW + jnp.arange(band)
        mask = (s_pos[None, :] <= t[:, None]) & (s_pos[None, :] > t[:, None] - WINDOW) & (s_pos[None, :] >= 0)
        s = jnp.einsum('btgrd,bsgd->btgrs', qb, kb).astype(jnp.float32) * scale
        p = masked_softmax(s, mask[None, :, None, None, :])
        return jnp.einsum('btgrs,bsgd->btgrd', p.astype(vb.dtype), vb)

    out = lax.map(block, jnp.arange(S // WIN_Q_BLOCK))
    return jnp.moveaxis(out, 0, 1).reshape(B, S, G, R, dh)


def nsa_attention(q, k_cmp, v_cmp, k_sel, v_sel, k_win, v_win, br_gate,
                  cmp_k_pe, cmp_k_w1, cmp_k_w2, cmp_v_pe, cmp_v_w1, cmp_v_w2):
    B, S, _ = q.shape
    G, R, dh = N_KV_HEADS, Q_PER_KV, HEAD_DIM
    scale = dh ** -0.5
    q = q.reshape(B, S, G, R, dh)
    kv = lambda a: a.reshape(B, S, G, dh)
    t_pos = jnp.arange(S)
    kc = compress_blocks(kv(k_cmp), cmp_k_pe, cmp_k_w1, cmp_k_w2)
    vc = compress_blocks(kv(v_cmp), cmp_v_pe, cmp_v_w1, cmp_v_w2)
    n_cmp = kc.shape[1]
    cmp_end = jnp.arange(n_cmp) * CMP_STRIDE + CMP_BLOCK - 1
    cmp_mask = cmp_end[None, :] <= t_pos[:, None]
    s_cmp = jnp.einsum('btgrd,bcgd->btgrc', q, kc).astype(jnp.float32) * scale
    p_cmp = masked_softmax(s_cmp, cmp_mask[None, :, None, None, :])
    o_cmp = jnp.einsum('btgrc,bcgd->btgrd', p_cmp.astype(vc.dtype), vc)
    n_sel_blocks = S // SEL_BLOCK
    imp = jnp.einsum('btgrc,cj->btgj', p_cmp, cmp_sel_overlap(n_cmp, n_sel_blocks))
    blk = jnp.arange(n_sel_blocks)[None, :]
    cur = (t_pos // SEL_BLOCK)[:, None]
    forced = (blk == 0) | (blk == cur) | (blk == cur - 1)
    causal_blk = blk * SEL_BLOCK <= t_pos[:, None]
    imp = jnp.where(forced[None, :, None, :], SEL_FORCE, imp)
    imp = jnp.where(causal_blk[None, :, None, :], imp, -SEL_FORCE)
    top_val, top_idx = lax.top_k(imp, min(SEL_TOPK, n_sel_blocks))
    top_valid = top_val > -0.5 * SEL_FORCE
    o_sel = selected_attention(q, kv(k_sel), kv(v_sel), top_idx, top_valid)
    o_win = window_attention(q, kv(k_win), kv(v_win))
    g = jax.nn.sigmoid(br_gate.astype(jnp.float32)).reshape(B, S, N_BRANCH, G, R)[..., None]
    o = g[:, :, 0] * o_cmp + g[:, :, 1] * o_sel + g[:, :, 2] * o_win
    return o.reshape(B, S, D_ATTN).astype(br_gate.dtype)


def setup_inputs(seed: int = 0) -> dict:
    key = jax.random.key(seed)
    ks = jax.random.split(key, 20)
    f32 = jnp.float32
    L = DEPTH

    def nrm(k, shape, scale):
        return jax.random.normal(k, shape, f32) * scale

    u = jax.random.uniform(ks[9], (L, D_RNN), f32, LRU_A_MIN ** (1.0 / LRU_C), LRU_A_MAX ** (1.0 / LRU_C))
    return {
        "x": nrm(ks[0], (BATCH, SEQ, D_MODEL), 1.0),
        "norm1_w": 1.0 + nrm(ks[1], (L, D_MODEL), 0.02),
        "w_in": nrm(ks[2], (L, D_MODEL, D_IN), D_MODEL ** -0.5),
        "conv_w": nrm(ks[3], (L, CONV_WIDTH, D_RNN), CONV_WIDTH ** -0.5),
        "conv_b": nrm(ks[4], (L, D_RNN), 0.01),
        "rg_wa": nrm(ks[5], (L, RNN_HEADS, RNN_HEAD_DIM, RNN_HEAD_DIM), RNN_HEAD_DIM ** -0.5),
        "rg_ba": nrm(ks[6], (L, D_RNN), 0.01),
        "rg_wx": nrm(ks[7], (L, RNN_HEADS, RNN_HEAD_DIM, RNN_HEAD_DIM), RNN_HEAD_DIM ** -0.5),
        "rg_bx": nrm(ks[8], (L, D_RNN), 0.01),
        "rg_lambda": jnp.log(u) - jnp.log1p(-u),
        "cmp_k_pe": nrm(ks[10], (L, CMP_BLOCK, HEAD_DIM), 0.1),
        "cmp_k_w1": nrm(ks[11], (L, CMP_BLOCK * HEAD_DIM, CMP_HIDDEN), (CMP_BLOCK * HEAD_DIM) ** -0.5),
        "cmp_k_w2": nrm(ks[12], (L, CMP_HIDDEN, HEAD_DIM), CMP_HIDDEN ** -0.5),
        "cmp_v_pe": nrm(ks[13], (L, CMP_BLOCK, HEAD_DIM), 0.1),
        "cmp_v_w1": nrm(ks[14], (L, CMP_BLOCK * HEAD_DIM, CMP_HIDDEN), (CMP_BLOCK * HEAD_DIM) ** -0.5),
        "cmp_v_w2": nrm(ks[15], (L, CMP_HIDDEN, HEAD_DIM), CMP_HIDDEN ** -0.5),
        "w_out": nrm(ks[16], (L, D_MIX, D_MODEL), D_MIX ** -0.5),
        "normf_w": 1.0 + nrm(ks[17], (D_MODEL,), 0.02),
    }


def reference(x, norm1_w, w_in, conv_w, conv_b, rg_wa, rg_ba, rg_wx, rg_bx, rg_lambda,
              cmp_k_pe, cmp_k_w1, cmp_k_w2, cmp_v_pe, cmp_v_w1, cmp_v_w2, w_out, normf_w):
    split_at = [int(v) for v in np.cumsum(SPLIT_SIZES)[:-1]]
    for l in range(DEPTH):
        h = rms_norm(x, norm1_w[l])
        proj = h @ w_in[l]
        (rnn_x, rnn_gate, q, k_cmp, v_cmp, k_sel, v_sel, k_win, v_win,
         attn_gate, br_gate) = jnp.split(proj, split_at, axis=-1)
        rnn_in = causal_depthwise_conv(rnn_x, conv_w[l], conv_b[l])
        rnn_out = rg_lru(rnn_in, rg_wa[l], rg_ba[l], rg_wx[l], rg_bx[l], rg_lambda[l]) * jax.nn.silu(rnn_gate)
        attn = nsa_attention(q, k_cmp, v_cmp, k_sel, v_sel, k_win, v_win, br_gate,
                             cmp_k_pe[l], cmp_k_w1[l], cmp_k_w2[l], cmp_v_pe[l], cmp_v_w1[l], cmp_v_w2[l])
        attn_out = attn * jax.nn.silu(attn_gate)
        x = x + jnp.concatenate([rnn_out, attn_out], axis=-1) @ w_out[l]
    return rms_norm(x, normf_w)
```

```cpp
#include <hip/hip_runtime.h>
#include <cstdio>
#include <cstdint>
#include <cmath>

namespace {
constexpr int B = 16, S = 2048, DM = 1024, M = B * S;
constexpr int DIN = 2840;
constexpr int C_RX = 0, C_RG = 512, C_Q = 1024, C_KC = 1536, C_VC = 1664, C_KS = 1792, C_VS = 1920, C_KW = 2048, C_VW = 2176, C_AG = 2304, C_BG = 2816;
constexpr int NC = 127, NSB = 32;
constexpr float EPS = 1e-6f;

__device__ __forceinline__ float wave_sum(float v) {
#pragma unroll
  for (int o = 1; o < 64; o <<= 1) v += __shfl_xor(v, o);
  return v;
}
__device__ __forceinline__ float wave_max(float v) {
#pragma unroll
  for (int o = 1; o < 64; o <<= 1) v = fmaxf(v, __shfl_xor(v, o));
  return v;
}
__device__ __forceinline__ float sigmoidf_(float x) { return 1.0f / (1.0f + expf(-x)); }
__device__ __forceinline__ float siluf_(float x) { return x / (1.0f + expf(-x)); }

__global__ void __launch_bounds__(256) k_rmsnorm(const float* __restrict__ x, const float* __restrict__ w, float* __restrict__ y, int rows) {
  const int wid = threadIdx.x >> 6, lane = threadIdx.x & 63;
  const int row = blockIdx.x * 4 + wid;
  if (row >= rows) return;
  const float4* xr = (const float4*)(x + (size_t)row * DM);
  float4 v[4]; float s = 0.f;
#pragma unroll
  for (int j = 0; j < 4; ++j) { v[j] = xr[lane + 64 * j]; s += v[j].x * v[j].x + v[j].y * v[j].y + v[j].z * v[j].z + v[j].w * v[j].w; }
  s = wave_sum(s);
  const float r = rsqrtf(s * (1.0f / DM) + EPS);
  float4* yr = (float4*)(y + (size_t)row * DM);
  const float4* wr = (const float4*)w;
#pragma unroll
  for (int j = 0; j < 4; ++j) { const float4 ww = wr[lane + 64 * j]; float4 o; o.x = v[j].x * r * ww.x; o.y = v[j].y * r * ww.y; o.z = v[j].z * r * ww.z; o.w = v[j].w * r * ww.w; yr[lane + 64 * j] = o; }
}

__global__ void __launch_bounds__(256) k_gemm(const float* __restrict__ A, const float* __restrict__ Bm, float* __restrict__ C, const float* __restrict__ R, int Mr, int N, int K) {
  __shared__ float sA[16][64 + 4];
  __shared__ float sB[16][64 + 4];
  const int tx = threadIdx.x & 15, ty = threadIdx.x >> 4;
  const int m0 = blockIdx.y * 64, n0 = blockIdx.x * 64;
  float acc[4][4];
#pragma unroll
  for (int i = 0; i < 4; ++i)
#pragma unroll
    for (int j = 0; j < 4; ++j) acc[i][j] = 0.f;
  for (int k0 = 0; k0 < K; k0 += 16) {
#pragma unroll
    for (int i = 0; i < 4; ++i) { const int e = threadIdx.x + 256 * i; const int r = e >> 4, c = e & 15; sA[c][r] = A[(size_t)(m0 + r) * K + k0 + c]; }
#pragma unroll
    for (int i = 0; i < 4; ++i) { const int e = threadIdx.x + 256 * i; const int r = e >> 6, c = e & 63; sB[r][c] = (n0 + c < N) ? Bm[(size_t)(k0 + r) * N + n0 + c] : 0.f; }
    __syncthreads();
#pragma unroll
    for (int k = 0; k < 16; ++k) {
      float a[4], b[4];
#pragma unroll
      for (int i = 0; i < 4; ++i) a[i] = sA[k][ty * 4 + i];
#pragma unroll
      for (int j = 0; j < 4; ++j) b[j] = sB[k][tx * 4 + j];
#pragma unroll
      for (int i = 0; i < 4; ++i)
#pragma unroll
        for (int j = 0; j < 4; ++j) acc[i][j] = fmaf(a[i], b[j], acc[i][j]);
    }
    __syncthreads();
  }
#pragma unroll
  for (int i = 0; i < 4; ++i)
#pragma unroll
    for (int j = 0; j < 4; ++j) { const int r = m0 + ty * 4 + i, c = n0 + tx * 4 + j; if (c < N) { float v = acc[i][j]; if (R) v += R[(size_t)r * N + c]; C[(size_t)r * N + c] = v; } }
}

__global__ void __launch_bounds__(512) k_rnn_gates(const float* __restrict__ proj, const float* __restrict__ conv_w, const float* __restrict__ conv_b,
                                                    const float* __restrict__ wa, const float* __restrict__ ba, const float* __restrict__ wx, const float* __restrict__ bx,
                                                    const float* __restrict__ lam, float* __restrict__ a_out, float* __restrict__ u_out) {
  __shared__ float xin[512];
  const int row = blockIdx.x, t = row % S, c = threadIdx.x;
  float v = conv_b[c];
#pragma unroll
  for (int k = 0; k < 4; ++k) { const int tt = t - 3 + k; if (tt >= 0) v += conv_w[k * 512 + c] * proj[(size_t)(row - 3 + k) * DIN + C_RX + c]; }
  xin[c] = v;
  __syncthreads();
  const int h = c >> 6, j = c & 63;
  float sa = 0.f, sx = 0.f;
  for (int i = 0; i < 64; ++i) { const float xi = xin[h * 64 + i]; sa = fmaf(xi, wa[(h * 64 + i) * 64 + j], sa); sx = fmaf(xi, wx[(h * 64 + i) * 64 + j], sx); }
  const float r = sigmoidf_(sa + ba[c]);
  const float ig = sigmoidf_(sx + bx[c]);
  const float L = lam[c];
  const float ls = -log1pf(expf(-L));
  const float log_a = 8.0f * r * ls;
  const float a = expf(log_a);
  const float u = sqrtf(-expm1f(2.0f * log_a)) * (ig * v);
  a_out[(size_t)row * 512 + c] = a;
  u_out[(size_t)row * 512 + c] = u;
}
__global__ void __launch_bounds__(64) k_rnn_scan(const float* __restrict__ a_in, const float* __restrict__ u_in, const float* __restrict__ proj, float* __restrict__ mix) {
  const int idx = blockIdx.x * 64 + threadIdx.x;
  const int b = idx / 512, c = idx % 512;
  float h = 0.f;
  for (int t = 0; t < S; ++t) {
    const size_t row = (size_t)b * S + t;
    h = fmaf(a_in[row * 512 + c], h, u_in[row * 512 + c]);
    const float g = proj[row * DIN + C_RG + c];
    mix[row * DM + c] = h * siluf_(g);
  }
}

__global__ void __launch_bounds__(256) k_compress(const float* __restrict__ proj, int col0, const float* __restrict__ pe, const float* __restrict__ w1, const float* __restrict__ w2, float* __restrict__ outc) {
  __shared__ float flat[2048];
  __shared__ float hid[256];
  const int g = blockIdx.x & 1, c = (blockIdx.x >> 1) % NC, b = blockIdx.x / (2 * NC);
  for (int e = threadIdx.x; e < 2048; e += 256) { const int l = e >> 6, d = e & 63; flat[e] = proj[(size_t)(b * S + 16 * c + l) * DIN + col0 + g * 64 + d] + pe[l * 64 + d]; }
  __syncthreads();
  float s = 0.f;
  for (int k = 0; k < 2048; ++k) s = fmaf(flat[k], w1[(size_t)k * 256 + threadIdx.x], s);
  hid[threadIdx.x] = siluf_(s);
  __syncthreads();
  if (threadIdx.x < 64) { float o = 0.f; for (int k = 0; k < 256; ++k) o = fmaf(hid[k], w2[k * 64 + threadIdx.x], o); outc[((size_t)(b * NC + c) * 2 + g) * 64 + threadIdx.x] = o; }
}

__global__ void __launch_bounds__(256) k_attn(const float* __restrict__ proj, const float* __restrict__ kc, const float* __restrict__ vc, float* __restrict__ mix) {
  __shared__ float q[4][64];
  __shared__ float pc[4][128];
  __shared__ float sc[4][512];
  __shared__ float imp[32];
  __shared__ int sel[8];
  __shared__ int nsel_s;
  const int g = blockIdx.x & 1, row = blockIdx.x >> 1, t = row % S, b = row / S;
  const int r = threadIdx.x >> 6, lane = threadIdx.x & 63;
  const float scale = 0.125f;
  const float* prow = proj + (size_t)row * DIN;
  q[r][lane] = prow[C_Q + (g * 4 + r) * 64 + lane];
  pc[r][lane] = 0.f; pc[r][lane + 64] = 0.f;
  __syncthreads();
  const int ncmp = (t >= 31) ? min(NC, (t - 31) / 16 + 1) : 0;
  float o_cmp = 0.f;
  {
    float s0 = -INFINITY, s1 = -INFINITY;
    if (lane < ncmp) { const float* kr = kc + ((size_t)(b * NC + lane) * 2 + g) * 64; float s = 0.f; for (int d = 0; d < 64; ++d) s = fmaf(q[r][d], kr[d], s); s0 = s * scale; }
    if (lane + 64 < ncmp) { const float* kr = kc + ((size_t)(b * NC + lane + 64) * 2 + g) * 64; float s = 0.f; for (int d = 0; d < 64; ++d) s = fmaf(q[r][d], kr[d], s); s1 = s * scale; }
    float m = wave_max(fmaxf(s0, s1));
    if (!(m > -INFINITY)) m = 0.f;
    const float e0 = (lane < ncmp) ? expf(s0 - m) : 0.f, e1 = (lane + 64 < ncmp) ? expf(s1 - m) : 0.f;
    const float den = wave_sum(e0 + e1);
    const float inv = den > 0.f ? 1.0f / den : 1.0f;
    pc[r][lane] = e0 * inv; pc[r][lane + 64] = e1 * inv;
    __syncthreads();
    for (int c = 0; c < ncmp; ++c) o_cmp = fmaf(pc[r][c], vc[((size_t)(b * NC + c) * 2 + g) * 64 + lane], o_cmp);
  }
  const int cur = t >> 6;
  if (threadIdx.x < 32) {
    const int j = threadIdx.x;
    float v = 0.f;
    for (int rr = 0; rr < 4; ++rr) {
      float a = 0.f;
      for (int k = 0; k < 3; ++k) if (4 * j + k < NC) a += pc[rr][4 * j + k];
      if (4 * j + 3 < NC) a += 0.5f * pc[rr][4 * j + 3];
      if (j > 0) a += 0.5f * pc[rr][4 * j - 1];
      v += a;
    }
    if (j == 0 || j == cur || j == cur - 1) v = 1e9f;
    if (j * 64 > t) v = -1e9f;
    imp[j] = v;
  }
  __syncthreads();
  if (threadIdx.x == 0) nsel_s = 0;
  __syncthreads();
  if (threadIdx.x < 32) {
    const int j = threadIdx.x; const float v = imp[j];
    int rank = 0;
    for (int jj = 0; jj < 32; ++jj) { const float w = imp[jj]; if (w > v || (w == v && jj < j)) ++rank; }
    if (rank < 8 && v > -0.5e9f) { const int pos = atomicAdd(&nsel_s, 1); sel[pos] = j; }
  }
  __syncthreads();
  const int nsel = nsel_s;
  float o_sel = 0.f;
  {
    for (int si = 0; si < nsel; ++si) {
      const int pos = sel[si] * 64 + lane;
      float s = -INFINITY;
      if (pos <= t) { const float* kr = proj + (size_t)(b * S + pos) * DIN + C_KS + g * 64; float a = 0.f; for (int d = 0; d < 64; ++d) a = fmaf(q[r][d], kr[d], a); s = a * scale; }
      sc[r][si * 64 + lane] = s;
    }
    float m = -INFINITY;
    for (int si = 0; si < nsel; ++si) m = fmaxf(m, sc[r][si * 64 + lane]);
    m = wave_max(m);
    if (!(m > -INFINITY)) m = 0.f;
    float den = 0.f;
    for (int si = 0; si < nsel; ++si) { const float s = sc[r][si * 64 + lane]; const float e = (s > -INFINITY) ? expf(s - m) : 0.f; sc[r][si * 64 + lane] = e; den += e; }
    den = wave_sum(den);
    const float inv = den > 0.f ? 1.0f / den : 1.0f;
    __syncthreads();
    for (int si = 0; si < nsel; ++si) {
      const int p0 = sel[si] * 64;
      for (int l = 0; l < 64; ++l) { const float p = sc[r][si * 64 + l]; if (p != 0.f) o_sel = fmaf(p * inv, proj[(size_t)(b * S + p0 + l) * DIN + C_VS + g * 64 + lane], o_sel); }
    }
  }
  __syncthreads();
  float o_win = 0.f;
  {
    const int s_lo = max(0, t - 511);
    const int nk = t - s_lo + 1;
    for (int i = lane; i < nk; i += 64) {
      const float* kr = proj + (size_t)(b * S + s_lo + i) * DIN + C_KW + g * 64; float a = 0.f; for (int d = 0; d < 64; ++d) a = fmaf(q[r][d], kr[d], a);
      sc[r][i] = a * scale;
    }
    float m = -INFINITY;
    for (int i = lane; i < nk; i += 64) m = fmaxf(m, sc[r][i]);
    m = wave_max(m);
    float den = 0.f;
    for (int i = lane; i < nk; i += 64) { const float e = expf(sc[r][i] - m); sc[r][i] = e; den += e; }
    den = wave_sum(den);
    const float inv = 1.0f / den;
    __syncthreads();
    for (int i = 0; i < nk; ++i) o_win = fmaf(sc[r][i] * inv, proj[(size_t)(b * S + s_lo + i) * DIN + C_VW + g * 64 + lane], o_win);
  }
  const int hq = g * 4 + r;
  const float g0 = sigmoidf_(prow[C_BG + 0 * 8 + hq]), g1 = sigmoidf_(prow[C_BG + 1 * 8 + hq]), g2 = sigmoidf_(prow[C_BG + 2 * 8 + hq]);
  const float o = g0 * o_cmp + g1 * o_sel + g2 * o_win;
  const float ag = prow[C_AG + hq * 64 + lane];
  mix[(size_t)row * DM + 512 + hq * 64 + lane] = o * siluf_(ag);
}
}

extern "C" void kernel_launch(void* const* d_in, const int* in_sizes, int n_in, void* d_out, int out_size, void* d_ws, size_t ws_size, hipStream_t stream) {
  const float* x = (const float*)d_in[0];
  const float* norm1_w = (const float*)d_in[1];
  const float* w_in = (const float*)d_in[2];
  const float* conv_w = (const float*)d_in[3];
  const float* conv_b = (const float*)d_in[4];
  const float* rg_wa = (const float*)d_in[5];
  const float* rg_ba = (const float*)d_in[6];
  const float* rg_wx = (const float*)d_in[7];
  const float* rg_bx = (const float*)d_in[8];
  const float* rg_lambda = (const float*)d_in[9];
  const float* cmp_k_pe = (const float*)d_in[10];
  const float* cmp_k_w1 = (const float*)d_in[11];
  const float* cmp_k_w2 = (const float*)d_in[12];
  const float* cmp_v_pe = (const float*)d_in[13];
  const float* cmp_v_w1 = (const float*)d_in[14];
  const float* cmp_v_w2 = (const float*)d_in[15];
  const float* w_out = (const float*)d_in[16];
  const float* normf_w = (const float*)d_in[17];
  float* out = (float*)d_out;
  char* ws = (char*)d_ws;
  float* proj = (float*)ws;
  size_t off = (size_t)M * DIN * 4;
  float* mix = (float*)(ws + off); off += (size_t)M * DM * 4;
  float* kcb = (float*)(ws + off); off += (size_t)B * NC * 2 * 64 * 4;
  float* vcb = (float*)(ws + off); off += (size_t)B * NC * 2 * 64 * 4;
  float* hbuf = out;
  float* abuf = out; float* ubuf = out + (size_t)M * 512;
  if (off > ws_size) { fprintf(stderr, "ws too small\n"); return; }

  k_rmsnorm<<<M / 4, 256, 0, stream>>>(x, norm1_w, hbuf, M);
  k_gemm<<<dim3((DIN + 63) / 64, M / 64), 256, 0, stream>>>(hbuf, w_in, proj, nullptr, M, DIN, DM);
  k_rnn_gates<<<M, 512, 0, stream>>>(proj, conv_w, conv_b, rg_wa, rg_ba, rg_wx, rg_bx, rg_lambda, abuf, ubuf);
  k_rnn_scan<<<B * 512 / 64, 64, 0, stream>>>(abuf, ubuf, proj, mix);
  k_compress<<<B * NC * 2, 256, 0, stream>>>(proj, C_KC, cmp_k_pe, cmp_k_w1, cmp_k_w2, kcb);
  k_compress<<<B * NC * 2, 256, 0, stream>>>(proj, C_VC, cmp_v_pe, cmp_v_w1, cmp_v_w2, vcb);
  k_attn<<<M * 2, 256, 0, stream>>>(proj, kcb, vcb, mix);
  float* y = proj;
  k_gemm<<<dim3(DM / 64, M / 64), 256, 0, stream>>>(mix, w_out, y, x, M, DM, DM);
  k_rmsnorm<<<M / 4, 256, 0, stream>>>(y, normf_w, out, M);
}
```

```cpp
#include <hip/hip_runtime.h>
#include <cstdio>
#include <cstdint>
#include <cmath>
namespace pg8 {
#define PG8_LAS __attribute__((address_space(3)))
typedef unsigned short bf16_t;
typedef short bf16x8 __attribute__((ext_vector_type(8)));
typedef float f32x4 __attribute__((ext_vector_type(4)));
typedef unsigned u32x4 __attribute__((ext_vector_type(4)));
constexpr int BM = 256, BK = 64, HALF = 128, HTB = HALF * BK * 2  , STAGE_BYTES = 8 * HTB, NXCD = 8, WGM = 8;

__host__ __device__ __forceinline__ int lds_byte(int r, int c) { const int st = (r >> 4) * 2 + (c >> 5), rr = r & 15, cc = c & 31, ob = rr * 64 + cc * 2; return st * 1024 + (ob ^ (((ob >> 9) & 1) << 5)); }
__host__ __device__ __forceinline__ void stage_rc(int b, int& R, int& C) { const int st = b / 1024, sb = b % 1024, swz = sb ^ (((sb >> 9) & 1) << 5); R = (st >> 1) * 16 + swz / 64; C = (st & 1) * 32 + (swz % 64) / 2; }
__host__ __device__ __forceinline__ int perm32(int rho) { const int n = rho >> 4, i = rho & 15; return 8 * (i >> 2) + 4 * n + (i & 3); }

struct Unit { int pm, pn; };
struct Gemm { const bf16_t* A; const bf16_t* Bt; int M, N, K; };

struct StaticOrder {
    int nM, nN, nwg, G, c;
    __host__ __device__ void init(int M, int N, int G_, int c_) { nM = M / BM; nN = N / BM; nwg = nM * nN; G = G_; c = c_; }
    __host__ __device__ bool next(int i, Unit& u) const {
        const long L = (long)i * G + c; if (L >= nwg) return false;
        int wgid = (int)L; { const int q = nwg / NXCD, r = nwg % NXCD, xcd = wgid % NXCD, off = wgid / NXCD; wgid = (xcd < r ? xcd * (q + 1) : r * (q + 1) + (xcd - r) * q) + off; }
        const int nig = WGM * nN, gid = wgid / nig, fm = gid * WGM, gsz = (nM - fm) < WGM ? (nM - fm) : WGM;
        u.pm = fm + ((wgid % nig) % gsz); u.pn = (wgid % nig) / gsz; return true;
    }
    __device__ __forceinline__ void a_ready(const Unit&) const {}
    __device__ __forceinline__ void done(const Unit&) const {}
};

__device__ __forceinline__ unsigned cvt_pk_bf16(float lo, float hi) { unsigned r; asm volatile("v_cvt_pk_bf16_f32 %0, %1, %2" : "=v"(r) : "v"(lo), "v"(hi)); return r; }
typedef float f32x2 __attribute__((ext_vector_type(2)));
__device__ __forceinline__ f32x2 gelu_pk(f32x2 v) {
    const f32x2 av = __builtin_elementwise_abs(v), d = av * 0.2316418882f + 1.0f;
    f32x2 t; t.x = __builtin_amdgcn_rcpf(d.x); t.y = __builtin_amdgcn_rcpf(d.y);
    f32x2 q = t * 0.5307027145f + (-0.7265760135f); q = q * t + 0.7107068705f; q = q * t + (-0.142248368f); q = q * t + 0.127414796f; q = q * t;
    const f32x2 s = (v * v) * (-0.72134752044f);
    f32x2 e; e.x = __builtin_amdgcn_exp2f(s.x); e.y = __builtin_amdgcn_exp2f(s.y);
    const f32x2 m = v * (q * e), r = v - m;
    f32x2 o; o.x = v.x < 0.f ? m.x : r.x; o.y = v.y < 0.f ? m.y : r.y; return o;
}

template <int ACT  > struct EpiBf16 {
    static constexpr bool PERM = true, AFTER_DRAIN = false; static_assert(ACT == 0 || ACT == 1, "EpiBf16: ACT is 0 (none) or 1 (gelu_pk)");
    bf16_t* O; int ldc; const float* bias; int split_cols; size_t split_stride; float scale0;
    __device__ __forceinline__ void operator()(const f32x4 (&acc)[2][2][4][2], const Unit& u, int wr, int wc, int fr, int fq) const {
        const int row0 = u.pm * BM + wr * 64 + fr; int colt = u.pn * BM; bf16_t* base = O;
        float sc = 1.f; if (split_cols) { const int t = colt / split_cols; base += (size_t)t * split_stride; colt -= t * split_cols; if (t == 0) sc = scale0; }
        const int col0 = colt + wc * 32 + 8 * fq, bcol0 = u.pn * BM + wc * 32 + 8 * fq;
        f32x4 bv[2][2];
#pragma unroll
        for (int bj = 0; bj < 2; ++bj)
#pragma unroll
            for (int n = 0; n < 2; ++n) bv[bj][n] = bias ? *(const f32x4*)(bias + bcol0 + bj * HALF + 4 * n) : (f32x4){0.f, 0.f, 0.f, 0.f};
#pragma unroll
        for (int ai = 0; ai < 2; ++ai)
#pragma unroll
            for (int m = 0; m < 4; ++m) { bf16_t* rowp = base + (size_t)(row0 + ai * HALF + m * 16) * ldc + col0;
#pragma unroll
                for (int bj = 0; bj < 2; ++bj) { f32x4 v0 = acc[ai][bj][m][0] + bv[bj][0], v1 = acc[ai][bj][m][1] + bv[bj][1];
                    if (ACT == 1) { f32x2 a = gelu_pk((f32x2){v0[0], v0[1]}), b = gelu_pk((f32x2){v0[2], v0[3]}), c = gelu_pk((f32x2){v1[0], v1[1]}), d = gelu_pk((f32x2){v1[2], v1[3]});
                        v0 = (f32x4){a.x, a.y, b.x, b.y}; v1 = (f32x4){c.x, c.y, d.x, d.y}; }
                    v0 = v0 * sc; v1 = v1 * sc; u32x4 w; w.x = cvt_pk_bf16(v0[0], v0[1]); w.y = cvt_pk_bf16(v0[2], v0[3]); w.z = cvt_pk_bf16(v1[0], v1[1]); w.w = cvt_pk_bf16(v1[2], v1[3]);
                    *(u32x4*)(rowp + bj * HALF) = w; } }
    }
};
struct EpiProj {
    static constexpr bool PERM = true, AFTER_DRAIN = false;
    bf16_t* O; int ldc; float qscale;
    __device__ __forceinline__ void operator()(const f32x4 (&acc)[2][2][4][2], const Unit& u, int wr, int wc, int fr, int fq) const {
        const int row0 = u.pm * BM + wr * 64 + fr; const int colt = u.pn * BM;
        const float sc = (u.pn == 4 || u.pn == 5) ? qscale : 1.f;
        const int col0 = colt + wc * 32 + 8 * fq;
#pragma unroll
        for (int ai = 0; ai < 2; ++ai)
#pragma unroll
            for (int m = 0; m < 4; ++m) { bf16_t* rowp = O + (size_t)(row0 + ai * HALF + m * 16) * ldc + col0;
#pragma unroll
                for (int bj = 0; bj < 2; ++bj) { f32x4 v0 = acc[ai][bj][m][0] * sc, v1 = acc[ai][bj][m][1] * sc;
                    u32x4 w; w.x = cvt_pk_bf16(v0[0], v0[1]); w.y = cvt_pk_bf16(v0[2], v0[3]); w.z = cvt_pk_bf16(v1[0], v1[1]); w.w = cvt_pk_bf16(v1[2], v1[3]);
                    *(u32x4*)(rowp + bj * HALF) = w; } }
    }
};
struct EpiResid {
    static constexpr bool PERM = false, AFTER_DRAIN = false;
    const float* base; float* out; float* ssq; int ldc;
    __device__ __forceinline__ void operator()(const f32x4 (&acc)[2][2][4][2], const Unit& u, int wr, int wc, int fr, int fq) const {
        const int col0 = u.pn * BM + wc * 32 + 4 * fq;
#pragma unroll
        for (int ai = 0; ai < 2; ++ai)
#pragma unroll
            for (int m = 0; m < 4; ++m) { const int row = u.pm * BM + ai * HALF + wr * 64 + m * 16 + fr; const size_t off = (size_t)row * ldc + col0; float q = 0.f;
#pragma unroll
                for (int bj = 0; bj < 2; ++bj)
#pragma unroll
                    for (int n = 0; n < 2; ++n) { const f32x4 v = acc[ai][bj][m][n] + *(const f32x4*)(base + off + bj * HALF + n * 16);
                        *(f32x4*)(out + off + bj * HALF + n * 16) = v; q += (v[0] * v[0] + v[1] * v[1]) + (v[2] * v[2] + v[3] * v[3]); }
                q += __shfl_xor(q, 16); q += __shfl_xor(q, 32);
                if (fq == 0) ssq[(size_t)row * 16 + u.pn * 4 + wc] = q; }
    }
};
template <class Epi, class Sched, bool ALIGN_EPI = false, bool SP2 = false>
__device__ __forceinline__ void gemm_phase(PG8_LAS unsigned char* lds, const Gemm g, const Sched& S, const Epi& E) {
    const int tid = threadIdx.x, wid = __builtin_amdgcn_readfirstlane(tid >> 6), lane = tid & 63, wr = wid >> 2, wc = wid & 3, fr = lane & 15, fq = lane >> 4;
    const int K = g.K, nt = K / BK;
    unsigned voffA[2], voffB[2];
#pragma unroll
    for (int i = 0; i < 2; ++i) { int R, C; stage_rc(tid * 16 + i * 8192, R, C); const int Rb = Epi::PERM ? ((R & ~31) + perm32(R & 31)) : R;
        voffA[i] = (unsigned)(R * K + C) * 2u; voffB[i] = (unsigned)(Rb * K + C) * 2u; }
    const size_t kstep = (size_t)(BK * 2);
    const size_t hstep = (size_t)HALF * K * 2;
    const size_t tstep = 2 * hstep;
    const unsigned ldsw = (unsigned)wid * 1024u;
    const int aoff = lds_byte(wr * 64 + fr, fq * 8), boff = lds_byte(wc * 32 + fr, fq * 8);
#define PG8_SA(b, h) (((b) * 2 + (h)) * HTB)
#define PG8_SB(b, h) ((4 + (b) * 2 + (h)) * HTB)
#define PG8_STAGE(bufoff, gbase, voff) do { _Pragma("unroll") for (int _i = 0; _i < 2; ++_i) \
        __builtin_amdgcn_global_load_lds((const unsigned*)((const char*)(gbase) + (voff)[_i]), (PG8_LAS unsigned*)(lds + (bufoff) + ldsw + _i * 8192), 16, 0, 0); } while (0)
#define PG8_LDA(dst, b, h) do { _Pragma("unroll") for (int m = 0; m < 4; ++m) _Pragma("unroll") for (int k = 0; k < 2; ++k) dst[m][k] = *(const PG8_LAS bf16x8*)(lds + PG8_SA(b, h) + aoff + m * 2048 + k * 1024); } while (0)
#define PG8_LDB(dst, b, h) do { _Pragma("unroll") for (int n = 0; n < 2; ++n) _Pragma("unroll") for (int k = 0; k < 2; ++k) dst[n][k] = *(const PG8_LAS bf16x8*)(lds + PG8_SB(b, h) + boff + n * 2048 + k * 1024); } while (0)
#define PG8_MMA(ai, bj, At, Bt) do { __builtin_amdgcn_s_setprio(1); _Pragma("unroll") for (int m = 0; m < 4; ++m) _Pragma("unroll") for (int n = 0; n < 2; ++n) _Pragma("unroll") for (int k = 0; k < 2; ++k) \
        acc[ai][bj][m][n] = __builtin_amdgcn_mfma_f32_16x16x32_bf16(Bt[n][k], At[m][k], acc[ai][bj][m][n], 0, 0, 0); __builtin_amdgcn_s_setprio(0); } while (0)
#define PG8_WAIT_V(n) asm volatile("s_waitcnt vmcnt(" #n ")" ::: "memory")
#define PG8_WAIT_L(n) asm volatile("s_waitcnt lgkmcnt(" #n ")" ::: "memory")
#define PG8_BAR __builtin_amdgcn_s_barrier()
#define PG8_SCHED __builtin_amdgcn_sched_barrier(0)
    Unit cur, nxt; int ui = 0;
    if (!S.next(0, cur)) return;
    f32x4 acc[2][2][4][2];
#pragma unroll
    for (int a = 0; a < 2; ++a)
#pragma unroll
        for (int b = 0; b < 2; ++b)
#pragma unroll
            for (int m = 0; m < 4; ++m)
#pragma unroll
                for (int n = 0; n < 2; ++n) acc[a][b][m][n] = (f32x4){0.f, 0.f, 0.f, 0.f};
    bf16x8 At[4][2], B0[2][2], B1[2][2];
    const char* cA = (const char*)g.A + (size_t)cur.pm * tstep; const char* cB = (const char*)g.Bt + (size_t)cur.pn * tstep;
    S.a_ready(cur);
    if constexpr (SP2) {
        PG8_STAGE(PG8_SB(0, 0), cB, voffB); PG8_STAGE(PG8_SB(0, 1), cB + hstep, voffB); PG8_STAGE(PG8_SA(0, 0), cA, voffA); PG8_STAGE(PG8_SA(0, 1), cA + hstep, voffA);
        if (wr == 1) PG8_BAR;
        PG8_WAIT_V(2); PG8_BAR;
        PG8_STAGE(PG8_SB(1, 0), cB + kstep, voffB); PG8_STAGE(PG8_SA(1, 0), cA + kstep, voffA); PG8_STAGE(PG8_SB(1, 1), cB + hstep + kstep, voffB);
        PG8_WAIT_V(6); PG8_BAR;
    } else {
        PG8_STAGE(PG8_SB(0, 0), cB, voffB); PG8_STAGE(PG8_SA(0, 0), cA, voffA); PG8_STAGE(PG8_SB(0, 1), cB + hstep, voffB); PG8_STAGE(PG8_SA(0, 1), cA + hstep, voffA);
        if (wr == 1) PG8_BAR;
        PG8_WAIT_V(4); PG8_BAR;
        PG8_STAGE(PG8_SB(1, 0), cB + kstep, voffB); PG8_STAGE(PG8_SA(1, 0), cA + kstep, voffA); PG8_STAGE(PG8_SB(1, 1), cB + hstep + kstep, voffB);
        PG8_WAIT_V(6); PG8_BAR;
    }
    for (;;) {
        const bool has_next = S.next(ui + 1, nxt);
        const char* nA = has_next ? (const char*)g.A + (size_t)nxt.pm * tstep : cA; const char* nB = has_next ? (const char*)g.Bt + (size_t)nxt.pn * tstep : cB;
        for (int t = 0; t < nt; t += 2) {
            const bool last = (t == nt - 2);
            const char* a1 = cA + (size_t)(t + 1) * kstep;
            const char* a2 = last ? nA : cA + (size_t)(t + 2) * kstep; const char* b2 = last ? nB : cB + (size_t)(t + 2) * kstep;
            const char* a3 = a2 + kstep; const char* b3 = b2 + kstep;
            if (last && has_next) S.a_ready(nxt);
            if constexpr (SP2) {
            PG8_LDB(B0, 0, 0); PG8_LDB(B1, 0, 1); PG8_SCHED; PG8_LDA(At, 0, 0); PG8_STAGE(PG8_SA(1, 1), a1 + hstep, voffA);
            PG8_WAIT_V(8); PG8_WAIT_L(0); PG8_BAR; PG8_MMA(0, 0, At, B0); PG8_MMA(0, 1, At, B1); PG8_BAR; PG8_SCHED;
            PG8_LDA(At, 0, 1); PG8_STAGE(PG8_SB(0, 0), b2, voffB); PG8_STAGE(PG8_SB(0, 1), b2 + hstep, voffB); PG8_STAGE(PG8_SA(0, 0), a2, voffA);
            PG8_WAIT_V(8); PG8_WAIT_L(0); PG8_BAR; PG8_MMA(1, 0, At, B0); PG8_MMA(1, 1, At, B1); PG8_BAR; PG8_SCHED;
            PG8_LDB(B0, 1, 0); PG8_LDB(B1, 1, 1); PG8_SCHED; PG8_LDA(At, 1, 0); PG8_STAGE(PG8_SA(0, 1), a2 + hstep, voffA);
            PG8_WAIT_V(8); PG8_WAIT_L(0); PG8_BAR; PG8_MMA(0, 0, At, B0); PG8_MMA(0, 1, At, B1); PG8_BAR; PG8_SCHED;
            PG8_LDA(At, 1, 1); PG8_STAGE(PG8_SB(1, 0), b3, voffB); PG8_STAGE(PG8_SB(1, 1), b3 + hstep, voffB); PG8_STAGE(PG8_SA(1, 0), a3, voffA);
            PG8_WAIT_V(8); PG8_WAIT_L(0); PG8_BAR; PG8_MMA(1, 0, At, B0); PG8_MMA(1, 1, At, B1); PG8_BAR; PG8_SCHED;
            } else {
            PG8_LDB(B0, 0, 0); PG8_SCHED; PG8_LDA(At, 0, 0); PG8_STAGE(PG8_SA(1, 1), a1 + hstep, voffA);
            PG8_WAIT_L(8); PG8_BAR; PG8_WAIT_L(0); PG8_MMA(0, 0, At, B0); PG8_BAR; PG8_SCHED;
            PG8_LDB(B1, 0, 1); PG8_STAGE(PG8_SB(0, 0), b2, voffB);
            PG8_BAR; PG8_WAIT_L(0); PG8_MMA(0, 1, At, B1); PG8_BAR;
            PG8_LDA(At, 0, 1); PG8_STAGE(PG8_SA(0, 0), a2, voffA);
            PG8_BAR; PG8_WAIT_L(0); PG8_MMA(1, 0, At, B0); PG8_BAR; PG8_SCHED;
            PG8_STAGE(PG8_SB(0, 1), b2 + hstep, voffB);
            PG8_WAIT_V(6); PG8_BAR; PG8_MMA(1, 1, At, B1); PG8_BAR;
            PG8_LDB(B0, 1, 0); PG8_SCHED; PG8_LDA(At, 1, 0); PG8_STAGE(PG8_SA(0, 1), a2 + hstep, voffA);
            PG8_WAIT_L(8); PG8_BAR; PG8_WAIT_L(0); PG8_MMA(0, 0, At, B0); PG8_BAR; PG8_SCHED;
            PG8_LDB(B1, 1, 1); PG8_STAGE(PG8_SB(1, 0), b3, voffB);
            PG8_BAR; PG8_WAIT_L(0); PG8_MMA(0, 1, At, B1); PG8_BAR;
            PG8_LDA(At, 1, 1); PG8_STAGE(PG8_SA(1, 0), a3, voffA);
            PG8_BAR; PG8_WAIT_L(0); PG8_MMA(1, 0, At, B0); PG8_BAR; PG8_SCHED;
            PG8_STAGE(PG8_SB(1, 1), b3 + hstep, voffB);
            PG8_WAIT_V(6); PG8_BAR; PG8_MMA(1, 1, At, B1); PG8_BAR;
            }
        }
        if constexpr (ALIGN_EPI) { if (wr == 0) PG8_BAR; }
        if constexpr (!Epi::AFTER_DRAIN) { E(acc, cur, wr, wc, fr, fq); S.done(cur); }
        if (!has_next) break;
#pragma unroll
        for (int a = 0; a < 2; ++a)
#pragma unroll
            for (int b = 0; b < 2; ++b)
#pragma unroll
                for (int m = 0; m < 4; ++m)
#pragma unroll
                    for (int n = 0; n < 2; ++n) acc[a][b][m][n] = (f32x4){0.f, 0.f, 0.f, 0.f};
        cur = nxt; cA = nA; cB = nB; ++ui;
        if constexpr (ALIGN_EPI) { if (wr == 1) PG8_BAR; }
    }
    PG8_WAIT_V(0);
    if constexpr (!ALIGN_EPI) { if (wr == 0) PG8_BAR; }
    PG8_BAR;
    if constexpr (Epi::AFTER_DRAIN) { E.fused(acc, cur, wr, wc, fr, fq, lds, wid, lane); S.done(cur); }
#undef PG8_SA
#undef PG8_SB
#undef PG8_STAGE
#undef PG8_LDA
#undef PG8_LDB
#undef PG8_MMA
#undef PG8_WAIT_V
#undef PG8_WAIT_L
#undef PG8_BAR
#undef PG8_SCHED
}
}
#define GAS __attribute__((address_space(1)))
#define LAS __attribute__((address_space(3)))
typedef unsigned short bf16;
typedef unsigned v4u __attribute__((ext_vector_type(4)));
typedef float f32x4 __attribute__((ext_vector_type(4)));
typedef short bf16x8 __attribute__((ext_vector_type(8)));
typedef GAS unsigned gu32;
typedef GAS unsigned long long gu64;
#define RLX_AGENT __ATOMIC_RELAXED, __HIP_MEMORY_SCOPE_AGENT
#define LDS_WAIT() asm volatile("s_waitcnt lgkmcnt(0)" ::: "memory")
#define VM_WAIT() asm volatile("s_waitcnt vmcnt(0)" ::: "memory")
__device__ __forceinline__ unsigned long long rt() { return __builtin_amdgcn_s_memrealtime(); }
__device__ __forceinline__ unsigned f2bf(float f) { unsigned u = __builtin_bit_cast(unsigned, f); return (u + 0x7fffu + ((u >> 16) & 1u)) >> 16; }
__device__ __forceinline__ unsigned pk2(float lo, float hi) { return f2bf(lo) | (f2bf(hi) << 16); }

#define XB_TMO      128
#define XB_XCNT(j)  (256  + 64 * (j))
#define XB_XSUB(j)  (1280 + 64 * (j))
#define XB_XGEN(j)  (2304 + 64 * (j))
#define XB_TOP      3328
#define XB_TOPGEN   3392
#define XCD_BAR_WORDS 3456
#define XB_SPIN_CAP (1u << 18)

__device__ __forceinline__ unsigned xb_ld(unsigned* p)              { return __hip_atomic_load(p, __ATOMIC_RELAXED, __HIP_MEMORY_SCOPE_AGENT); }
__device__ __forceinline__ unsigned xb_add(unsigned* p, unsigned v) { return __hip_atomic_fetch_add(p, v, __ATOMIC_RELAXED, __HIP_MEMORY_SCOPE_AGENT); }
__device__ __forceinline__ unsigned xb_xcc_id() { return (unsigned)__builtin_amdgcn_s_getreg((3 << 11) | 20) & 0xFu; }
#define XB_SPIN(cond, bar) do { unsigned _sp = 0; while (cond) { __builtin_amdgcn_s_sleep(1); \
    if ((++_sp & 255u) == 0u) { if (xb_ld(&(bar)[XB_TMO])) break; if (_sp > XB_SPIN_CAP) { atomicAdd(&(bar)[XB_TMO], 1u); break; } } } } while (0)

struct XcdBarrier {
    unsigned* bar; unsigned x;
    volatile LAS unsigned* st;
};

__device__ __forceinline__ XcdBarrier xcd_barrier_post(unsigned* bar, volatile LAS unsigned* st) {
    XcdBarrier b; b.bar = bar; b.x = xb_xcc_id(); b.st = st;
    if (threadIdx.x == 0) (void)xb_add(&bar[XB_XCNT(b.x)], 1u);
    return b;
}
__device__ __forceinline__ void xcd_barrier_complete(unsigned* bar, unsigned x, unsigned& nloc, unsigned& nx) {
    const unsigned G = gridDim.x * gridDim.y * gridDim.z;
    unsigned sum, cnt, mine, sp = 0u;
    for (;;) {
        sum = 0u; cnt = 0u; mine = 0u;
#pragma unroll
        for (unsigned j = 0; j < 16; ++j) { const unsigned c = xb_ld(&bar[XB_XCNT(j)]); sum += c; cnt += (c > 0u) ? 1u : 0u; mine = (j == x) ? c : mine; }
        if (sum == G) break;
        __builtin_amdgcn_s_sleep(1);
        if ((++sp & 255u) == 0u) { if (xb_ld(&bar[XB_TMO])) break; if (sp > XB_SPIN_CAP) { atomicAdd(&bar[XB_TMO], 1u); break; } }
    }
    nloc = mine > 0u ? mine : 1u; nx = cnt > 0u ? cnt : 1u;
}

__device__ __forceinline__ void xcd_barrier(const XcdBarrier& b) {
    asm volatile("s_waitcnt vmcnt(0)" ::: "memory");
    __syncthreads();
    if (threadIdx.x == 0) {
        unsigned* bar = b.bar;
        __builtin_amdgcn_s_waitcnt(0);
        unsigned nloc = b.st[0], nx = b.st[1];
        if (nloc == 0u) { xcd_barrier_complete(bar, b.x, nloc, nx); b.st[0] = nloc; b.st[1] = nx; }
        const unsigned old = xb_add(&bar[XB_XSUB(b.x)], 1u);
        const unsigned gen = old / nloc;
        if (old + 1u == (gen + 1u) * nloc) {
            __builtin_amdgcn_fence(__ATOMIC_RELEASE, "agent");
            asm volatile("s_waitcnt vmcnt(0)" ::: "memory");
            const unsigned og = xb_add(&bar[XB_TOP], 1u);
            const unsigned tg = og / nx;
            if (og + 1u == (tg + 1u) * nx) xb_add(&bar[XB_TOPGEN], 1u);
            else XB_SPIN(xb_ld(&bar[XB_TOPGEN]) == tg, bar);
            __builtin_amdgcn_fence(__ATOMIC_ACQUIRE, "agent");
            xb_add(&bar[XB_XGEN(b.x)], 1u);
            asm volatile("s_waitcnt vmcnt(0)" ::: "memory");
        } else {
            XB_SPIN(xb_ld(&bar[XB_XGEN(b.x)]) == gen, bar);
            __builtin_amdgcn_fence(__ATOMIC_ACQUIRE, "agent");
            asm volatile("s_waitcnt vmcnt(0)" ::: "memory");
        }
    }
    __syncthreads();
}
constexpr int NWAVES = 8;
constexpr int BATCH = 16, SEQ = 2048, DM = 1024, M = BATCH * SEQ;
constexpr int DIN = 2840, NP = 3072;
constexpr int C_RX = 0, C_RG = 512, C_Q = 1024, C_KC = 1536, C_VC = 1664, C_KS = 1792, C_VS = 1920, C_KW = 2048, C_VW = 2176, C_AG = 2304, C_BG = 2816;
constexpr int NC = 127, NCP = 128;
constexpr float EPS = 1e-6f;
constexpr float QSCALE = 0.125f * 1.4426950408889634f;

constexpr size_t MiB = 1u << 20, KiB = 1u << 10;
constexpr size_t WS_CTL = 0, CTL_ZERO_BYTES = 1 * MiB;
constexpr size_t WS_WIN = 2 * MiB, WS_WO = 8 * MiB;
constexpr size_t WS_W1K = 10 * MiB, WS_W1V = 11 * MiB, WS_W2K = 12 * MiB, WS_W2V = 12 * MiB + 64 * KiB, WS_WA = 12 * MiB + 128 * KiB, WS_WX = 12 * MiB + 192 * KiB;
constexpr size_t WS_B1P = 12 * MiB + 256 * KiB, WS_B1 = 12 * MiB + 320 * KiB;
constexpr size_t WS_RSUM = 13 * MiB, WS_KC = 14 * MiB, WS_VC = 14 * MiB + 512 * KiB, WS_SSQ = 16 * MiB, WS_HID = 18 * MiB;
constexpr size_t WS_XN = 32 * MiB, WS_PROJ = 96 * MiB, WS_MIX = 288 * MiB, WS_T0 = 352 * MiB, WS_T1 = 416 * MiB, WS_END = 480 * MiB;
constexpr int CW_TMO = 0, CW_CODE = 1, CW_BAR = 4096;

constexpr int RING_OFF = 0, RING_BYTES = 131072;
constexpr int LDSCTL_OFF = RING_BYTES, MISC_OFF = LDSCTL_OFF + 320;
constexpr int LDS_BYTES = 147456;

__device__ __forceinline__ float bf2f(bf16 v) { return __builtin_bit_cast(float, (unsigned)v << 16); }
__device__ __forceinline__ float wave_sum(float v) {
#pragma unroll
    for (int o = 1; o < 64; o <<= 1) v += __shfl_xor(v, o);
    return v;
}
__device__ __forceinline__ float wave_max(float v) {
#pragma unroll
    for (int o = 1; o < 64; o <<= 1) v = fmaxf(v, __shfl_xor(v, o));
    return v;
}
__device__ __forceinline__ float sigmoidf_(float x) { return 1.0f / (1.0f + __expf(-x)); }
__device__ __forceinline__ float siluf_(float x) { return x / (1.0f + __expf(-x)); }

namespace nsa {
using bf16x8 = __attribute__((ext_vector_type(8))) short;
using s16x4 = __attribute__((ext_vector_type(4))) short;
using f32x16 = __attribute__((ext_vector_type(16))) float;
using u32x4 = __attribute__((ext_vector_type(4))) unsigned;
typedef short v4i16_t __attribute__((ext_vector_type(4)));
constexpr int NSLOT = 4, SLOTB = 8192;
constexpr int L_K = 0, L_V = NSLOT * SLOTB, L_WS = 2 * NSLOT * SLOTB, L_OST = L_WS + 8 * 256, L_IMPB = L_OST, L_IMPF = L_OST + 32768, L_SELM = L_IMPF + 8192, L_END = L_SELM + 256;
static_assert(L_END <= RING_BYTES, "nsa LDS map");
#define NSA_SBAR() __builtin_amdgcn_sched_barrier(0)
#define NSA_WAIT_BAR(N) asm volatile("s_waitcnt vmcnt(" #N ") lgkmcnt(0)\n\ts_barrier" ::: "memory")
__device__ __forceinline__ int crow(int r, int hi) { return (r & 3) + 8 * (r >> 2) + 4 * hi; }
__device__ __forceinline__ void glds16(const void* gsrc, unsigned lds_dst) { unsigned keep;
    asm volatile("s_mov_b32 %0, m0\n\ts_mov_b32 m0, %2\n\ts_nop 0\n\tglobal_load_lds_dwordx4 %1, off\n\ts_mov_b32 m0, %0" : "=&s"(keep) : "v"(gsrc), "s"(lds_dst) : "memory"); }
typedef float f32x2_t __attribute__((ext_vector_type(2))); typedef __bf16 bf16x2_t __attribute__((ext_vector_type(2)));
__device__ __forceinline__ unsigned cvtpk(float lo, float hi) { f32x2_t v = {lo, hi}; bf16x2_t b = __builtin_convertvector(v, bf16x2_t); return __builtin_bit_cast(unsigned, b); }
__device__ __forceinline__ float xhalf(float v) { return __shfl_xor(v, 32); }

__device__ __forceinline__ void qkt(f32x16& p0, f32x16& p1, const LAS unsigned char* kslot, const bf16x8* qr, const f32x16& cinit, int r32, int hi) {
    const LAS unsigned char* kb = kslot + hi * 1024 + r32 * 16;
#pragma unroll
    for (int d0 = 0; d0 < 4; ++d0) {
        const bf16x8 b0 = *(const LAS bf16x8*)(kb + d0 * 2048);
        const bf16x8 b1 = *(const LAS bf16x8*)(kb + d0 * 2048 + 512);
        if (d0 == 0) { p0 = __builtin_amdgcn_mfma_f32_32x32x16_bf16(b0, qr[0], cinit, 0, 0, 0); p1 = __builtin_amdgcn_mfma_f32_32x32x16_bf16(b1, qr[0], cinit, 0, 0, 0); }
        else { p0 = __builtin_amdgcn_mfma_f32_32x32x16_bf16(b0, qr[d0], p0, 0, 0, 0); p1 = __builtin_amdgcn_mfma_f32_32x32x16_bf16(b1, qr[d0], p1, 0, 0, 0); }
    }
}
__device__ __forceinline__ s16x4 vtr(const LAS unsigned char* p) { return __builtin_bit_cast(s16x4, __builtin_amdgcn_ds_read_tr16_b64_v4i16((LAS v4i16_t*)p)); }
__device__ __forceinline__ void pv(f32x16* o, const LAS unsigned char* vp, bf16x8 pa0, bf16x8 pa1, bf16x8 pa2, bf16x8 pa3) {
#pragma unroll
    for (int d0 = 0; d0 < 2; ++d0) {
        s16x4 lo[4], hh[4];
#pragma unroll
        for (int ks = 0; ks < 4; ++ks) { lo[ks] = vtr(vp + d0 * 4096 + ks * 1024); hh[ks] = vtr(vp + d0 * 4096 + ks * 1024 + 512); }
#define NSA_PK(k) (bf16x8){lo[k][0], lo[k][1], lo[k][2], lo[k][3], hh[k][0], hh[k][1], hh[k][2], hh[k][3]}
        o[d0] = __builtin_amdgcn_mfma_f32_32x32x16_bf16(pa0, NSA_PK(0), o[d0], 0, 0, 0);
        o[d0] = __builtin_amdgcn_mfma_f32_32x32x16_bf16(pa1, NSA_PK(1), o[d0], 0, 0, 0);
        o[d0] = __builtin_amdgcn_mfma_f32_32x32x16_bf16(pa2, NSA_PK(2), o[d0], 0, 0, 0);
        o[d0] = __builtin_amdgcn_mfma_f32_32x32x16_bf16(pa3, NSA_PK(3), o[d0], 0, 0, 0);
#undef NSA_PK
    }
}
__device__ __forceinline__ float rowmax32(const f32x16& p0, const f32x16& p1) {
    float a = fmaxf(p0[0], p1[0]);
#pragma unroll
    for (int r = 1; r < 16; ++r) a = fmaxf(a, fmaxf(p0[r], p1[r]));
    return a;
}
template <int MODE> __device__ __forceinline__ void edge_mask(f32x16& p0, f32x16& p1, int tq, int hi) {
#pragma unroll
    for (int r = 0; r < 16; ++r) { const int kv = crow(r, hi);
        if (MODE == 1) { if (kv > tq) p0[r] = -INFINITY; if (kv + 32 > tq) p1[r] = -INFINITY; }
        else { if (kv <= tq) p0[r] = -INFINITY; if (kv + 32 <= tq) p1[r] = -INFINITY; } }
}

struct Tensors { const bf16* proj; const bf16* kc; const bf16* vc; bf16* mix; };

template <int THRL>
__device__ __forceinline__ void nsa_unit(int b, int g, int cur, const Tensors& T, LAS unsigned char* shm) {
    const int tid = threadIdx.x, lane = tid & 63, r32 = lane & 31, hi = lane >> 5;
    const int wid = __builtin_amdgcn_readfirstlane(tid >> 6);
    const int hr = wid >> 1, th = wid & 1, hq = g * 4 + hr;
    const int t0 = cur * 64, tq = 32 * th + r32;
    const size_t rowb = (size_t)b * SEQ;
    const unsigned lds0 = (unsigned)(size_t)shm;
    LAS float* wsf = (LAS float*)(shm + L_WS) + wid * 64;
    const int nwin = (cur < 8 ? cur : 8) + 1, wj0 = cur - (nwin - 1);
    const int NT = 2 + (cur + 1) + nwin;
    const bf16* kcg = T.kc + (size_t)(b * 2 + g) * 128 * 64; const bf16* vcg = T.vc + (size_t)(b * 2 + g) * 128 * 64;
    const bf16* pk = T.proj + rowb * NP + g * 64;
#define NSA_ISSUE(i_) do { const int i__ = (i_); if (i__ < NT) { const bf16* kp_; const bf16* vp_; int pitch_; \
        if (i__ < 2) { kp_ = kcg + (size_t)i__ * 64 * 64; vp_ = vcg + (size_t)i__ * 64 * 64; pitch_ = 64; } \
        else if (i__ < 3 + cur) { const int j_ = i__ - 2; kp_ = pk + (size_t)j_ * 64 * NP + C_KS; vp_ = pk + (size_t)j_ * 64 * NP + C_VS; pitch_ = NP; } \
        else { const int j_ = wj0 + (i__ - 3 - cur); kp_ = pk + (size_t)j_ * 64 * NP + C_KW; vp_ = pk + (size_t)j_ * 64 * NP + C_VW; pitch_ = NP; } \
        const unsigned so_ = (unsigned)((i__ & (NSLOT - 1)) * SLOTB) + (unsigned)wid * 1024u; \
        glds16(kp_ + (size_t)lane * pitch_ + wid * 8, (unsigned)__builtin_amdgcn_readfirstlane(lds0 + L_K + so_)); \
        glds16(vp_ + (size_t)(16 * (wid & 3) + (lane >> 2)) * pitch_ + (wid >> 2) * 32 + (lane & 3) * 8, (unsigned)__builtin_amdgcn_readfirstlane(lds0 + L_V + so_)); } } while (0)
    const bf16* qrow = T.proj + (rowb + t0 + tq) * NP;
    bf16x8 qr[4];
#pragma unroll
    for (int d0 = 0; d0 < 4; ++d0) qr[d0] = *(const bf16x8*)(qrow + C_Q + hq * 64 + d0 * 16 + hi * 8);
    const float gt0 = sigmoidf_(bf2f(qrow[C_BG + 0 * 8 + hq])), gt1 = sigmoidf_(bf2f(qrow[C_BG + 1 * 8 + hq])), gt2 = sigmoidf_(bf2f(qrow[C_BG + 2 * 8 + hq]));
    asm volatile("s_waitcnt vmcnt(0)" ::: "memory");
    NSA_ISSUE(0); NSA_ISSUE(1);
    const LAS unsigned char* kbase = shm + L_K;
    const LAS unsigned char* vbase = shm + L_V + ((lane >> 4) & 1) * 32 + (lane & 3) * 8 + (4 * hi + ((lane & 15) >> 2)) * 64;
    f32x16 oc[2]; oc[0] = f32x16{}; oc[1] = f32x16{};
    f32x16 o[2];
    f32x16 zero16 = f32x16{};
    u32x4 pw0, pw1, pw2, pw3;
#define NSA_PACK(P0, P1) do { \
        pw0 = (u32x4){cvtpk(P0[0], P0[1]), cvtpk(P0[2], P0[3]), cvtpk(P0[4], P0[5]), cvtpk(P0[6], P0[7])}; \
        pw1 = (u32x4){cvtpk(P0[8], P0[9]), cvtpk(P0[10], P0[11]), cvtpk(P0[12], P0[13]), cvtpk(P0[14], P0[15])}; \
        pw2 = (u32x4){cvtpk(P1[0], P1[1]), cvtpk(P1[2], P1[3]), cvtpk(P1[4], P1[5]), cvtpk(P1[6], P1[7])}; \
        pw3 = (u32x4){cvtpk(P1[8], P1[9]), cvtpk(P1[10], P1[11]), cvtpk(P1[12], P1[13]), cvtpk(P1[14], P1[15])}; } while (0)
#define NSA_PAF(k) __builtin_bit_cast(bf16x8, pw##k)
#define NSA_ACCUM(FAC) do { if (hi == 0) wsf[r32] = (FAC); asm volatile("s_waitcnt lgkmcnt(0)" ::: "memory"); \
        _Pragma("unroll") for (int r = 0; r < 16; ++r) { const float f_ = wsf[crow(r, hi)]; oc[0][r] += o[0][r] * f_; oc[1][r] += o[1][r] * f_; } \
        asm volatile("s_waitcnt lgkmcnt(0)" ::: "memory"); } while (0)

    NSA_WAIT_BAR(0);
    NSA_ISSUE(2); NSA_ISSUE(3);
    {
        const int t = t0 + tq; const int cmax = (t >= 31) ? ((t - 31) >> 4) : -1;
        const bool two = (cur >= 16);
        f32x16 a0, a1, b0, b1;
        qkt(a0, a1, kbase, qr, zero16, r32, hi);
        if (two) qkt(b0, b1, kbase + SLOTB, qr, zero16, r32, hi); else { b0 = f32x16{}; b1 = f32x16{}; }
#pragma unroll
        for (int r = 0; r < 16; ++r) { const int c = crow(r, hi);
            if (c > cmax) a0[r] = -INFINITY; if (c + 32 > cmax) a1[r] = -INFINITY;
            if (!two || c + 64 > cmax) b0[r] = -INFINITY; if (!two || c + 96 > cmax) b1[r] = -INFINITY; }
        float m = fmaxf(rowmax32(a0, a1), rowmax32(b0, b1)); m = fmaxf(m, xhalf(m));
        if (!(m > -INFINITY)) m = 0.f;
        float l = 0.f;
#pragma unroll
        for (int r = 0; r < 16; ++r) { a0[r] = __builtin_amdgcn_exp2f(a0[r] - m); a1[r] = __builtin_amdgcn_exp2f(a1[r] - m); b0[r] = __builtin_amdgcn_exp2f(b0[r] - m); b1[r] = __builtin_amdgcn_exp2f(b1[r] - m);
            l += (a0[r] + a1[r]) + (b0[r] + b1[r]); }
        l += xhalf(l);
        const float linv = l > 0.f ? 1.0f / l : 1.0f;
        float mainv[16], spill[16];
#pragma unroll
        for (int gi = 0; gi < 4; ++gi) {
            mainv[gi] = (a0[4 * gi] + a0[4 * gi + 1]) + (a0[4 * gi + 2] + 0.5f * a0[4 * gi + 3]); spill[gi] = 0.5f * a0[4 * gi + 3];
            mainv[4 + gi] = (a1[4 * gi] + a1[4 * gi + 1]) + (a1[4 * gi + 2] + 0.5f * a1[4 * gi + 3]); spill[4 + gi] = 0.5f * a1[4 * gi + 3];
            mainv[8 + gi] = (b0[4 * gi] + b0[4 * gi + 1]) + (b0[4 * gi + 2] + 0.5f * b0[4 * gi + 3]); spill[8 + gi] = 0.5f * b0[4 * gi + 3];
            mainv[12 + gi] = (b1[4 * gi] + b1[4 * gi + 1]) + (b1[4 * gi + 2] + 0.5f * b1[4 * gi + 3]); spill[12 + gi] = 0.5f * b1[4 * gi + 3];
        }
        LAS float* impb = (LAS float*)(shm + L_IMPB) + (size_t)(hr * 64 + tq) * 32;
        float other[16];
#pragma unroll
        for (int i = 0; i < 16; ++i) other[i] = xhalf(spill[i]);
#pragma unroll
        for (int i = 0; i < 16; ++i) { const float add = hi ? other[i] : (i > 0 ? other[i > 0 ? i - 1 : 0] : 0.f); impb[2 * i + hi] = (mainv[i] + add) * linv; }
        o[0] = f32x16{}; o[1] = f32x16{};
        NSA_PACK(a0, a1); pv(o, vbase, NSA_PAF(0), NSA_PAF(1), NSA_PAF(2), NSA_PAF(3));
        if (two) { NSA_PACK(b0, b1); pv(o, vbase + SLOTB, NSA_PAF(0), NSA_PAF(1), NSA_PAF(2), NSA_PAF(3)); }
        NSA_ACCUM(gt0 * linv);
    }
    asm volatile("s_waitcnt lgkmcnt(0)\n\ts_barrier" ::: "memory");
    {
        const int tk = tid >> 3, part = tid & 7;
        const LAS float* ib = (const LAS float*)(shm + L_IMPB);
        LAS float* impf = (LAS float*)(shm + L_IMPF) + tk * 32;
        float v[4];
#pragma unroll
        for (int q = 0; q < 4; ++q) { const int j = 4 * part + q;
            float s = ((ib[(0 * 64 + tk) * 32 + j] + ib[(1 * 64 + tk) * 32 + j]) + ib[(2 * 64 + tk) * 32 + j]) + ib[(3 * 64 + tk) * 32 + j];
            if (j == 0 || j == cur || j == cur - 1) s = 1e9f;
            if (j > cur) s = -1e9f;
            v[q] = s; impf[j] = s; }
        asm volatile("s_waitcnt lgkmcnt(0)\n\ts_barrier" ::: "memory");
        unsigned bits = 0u;
#pragma unroll
        for (int q = 0; q < 4; ++q) { const int j = 4 * part + q; int rank = 0;
#pragma unroll 8
            for (int jj = 0; jj < 32; ++jj) { const float w = impf[jj]; rank += (w > v[q] || (w == v[q] && jj < j)) ? 1 : 0; }
            if (rank < 8 && v[q] > -0.5e9f) bits |= 1u << j; }
        bits |= __shfl_xor(bits, 1); bits |= __shfl_xor(bits, 2); bits |= __shfl_xor(bits, 4);
        if (part == 0) ((LAS unsigned*)(shm + L_SELM))[tk] = bits;
    }
    asm volatile("s_waitcnt lgkmcnt(0)\n\ts_barrier" ::: "memory");
    const unsigned selbits = ((const LAS unsigned*)(shm + L_SELM))[tq];
    float mhat = 0.f, l_reg = 0.f; f32x16 negm = f32x16{};
    o[0] = f32x16{}; o[1] = f32x16{};
    for (int i = 2; i < NT; ++i) {
        if (i + 1 < NT) { NSA_WAIT_BAR(2); } else { NSA_WAIT_BAR(0); }
        NSA_ISSUE(i + 2);
        const bool is_sel = (i < 3 + cur);
        const int j = is_sel ? (i - 2) : (wj0 + (i - 3 - cur));
        const bool first = (i == 2) || (i == 3 + cur);
        if (i == 3 + cur) {
            float lt = l_reg + xhalf(l_reg); NSA_ACCUM(gt1 / lt);
            mhat = 0.f; l_reg = 0.f; negm = f32x16{}; o[0] = f32x16{}; o[1] = f32x16{};
        }
        const LAS unsigned char* ks = kbase + (i & (NSLOT - 1)) * SLOTB;
        const LAS unsigned char* vs = vbase + (i & (NSLOT - 1)) * SLOTB;
        f32x16 ci = negm;
        if (is_sel) { const bool on = (selbits >> j) & 1u;
#pragma unroll
            for (int r = 0; r < 16; ++r) ci[r] = on ? negm[r] : -INFINITY; }
        f32x16 p0, p1;
        qkt(p0, p1, ks, qr, ci, r32, hi);
        if (j == cur) edge_mask<1>(p0, p1, tq, hi);
        else if (!is_sel && i == 3 + cur && cur >= 8) edge_mask<2>(p0, p1, tq, hi);
        float rm = rowmax32(p0, p1); rm = fmaxf(rm, xhalf(rm));
        bool resc = false;
        if (first) {
            const float dl = (rm > -INFINITY) ? rm : 0.f; mhat = dl;
#pragma unroll
            for (int r = 0; r < 16; ++r) { p0[r] -= dl; p1[r] -= dl; negm[r] = -mhat; }
        } else if (__any(rm > (float)THRL)) {
            const float dl = fmaxf(rm, 0.f); mhat += dl;
#pragma unroll
            for (int r = 0; r < 16; ++r) { p0[r] -= dl; p1[r] -= dl; negm[r] = -mhat; }
            const float f = __builtin_amdgcn_exp2f(-dl); l_reg *= f; if (hi == 0) wsf[r32] = f; resc = true;
        }
        float sacc = 0.f;
#pragma unroll
        for (int r = 0; r < 16; ++r) { p0[r] = __builtin_amdgcn_exp2f(p0[r]); p1[r] = __builtin_amdgcn_exp2f(p1[r]); sacc += p0[r] + p1[r]; }
        l_reg += sacc;
        if (resc) { asm volatile("s_waitcnt lgkmcnt(0)" ::: "memory");
#pragma unroll
            for (int r = 0; r < 16; ++r) { const float f_ = wsf[crow(r, hi)]; o[0][r] *= f_; o[1][r] *= f_; }
            asm volatile("s_waitcnt lgkmcnt(0)" ::: "memory"); }
        NSA_PACK(p0, p1);
        pv(o, vs, NSA_PAF(0), NSA_PAF(1), NSA_PAF(2), NSA_PAF(3));
    }
    { float lt = l_reg + xhalf(l_reg); NSA_ACCUM(gt2 / lt); }
    asm volatile("s_waitcnt lgkmcnt(0)\n\ts_barrier" ::: "memory");
    {
        LAS bf16* stg = (LAS bf16*)(shm + L_OST) + wid * 2048;
#pragma unroll
        for (int r = 0; r < 16; ++r) { const int orow = crow(r, hi);
#pragma unroll
            for (int d0 = 0; d0 < 2; ++d0) stg[orow * 64 + d0 * 32 + r32] = (bf16)f2bf(oc[d0][r]); }
        asm volatile("s_waitcnt lgkmcnt(0)" ::: "memory");
#pragma unroll
        for (int i = 0; i < 4; ++i) { const int row = i * 8 + (lane >> 3), ch = lane & 7;
            const u32x4 ov = *(const LAS u32x4*)(stg + row * 64 + ch * 8);
            const size_t grow = rowb + t0 + 32 * th + row;
            const u32x4 gv = *(const u32x4*)(T.proj + grow * NP + C_AG + hq * 64 + ch * 8);
            u32x4 res;
#pragma unroll
            for (int e = 0; e < 4; ++e) { const float o_lo = __uint_as_float(ov[e] << 16), o_hi = __uint_as_float(ov[e] & 0xffff0000u);
                const float g_lo = __uint_as_float(gv[e] << 16), g_hi = __uint_as_float(gv[e] & 0xffff0000u);
                res[e] = cvtpk(o_lo * siluf_(g_lo), o_hi * siluf_(g_hi)); }
            *(u32x4*)(T.mix + grow * DM + 512 + hq * 64 + ch * 8) = res; }
    }
    asm volatile("s_waitcnt vmcnt(0) lgkmcnt(0)\n\ts_barrier" ::: "memory");
#undef NSA_ISSUE
#undef NSA_PACK
#undef NSA_PAF
#undef NSA_ACCUM
}

__device__ __forceinline__ void nsa_phase(LAS unsigned char* lds, const Tensors& T, int vcu, int G) {
    for (int v = vcu; v < 256; v += G) {
        const int bg = v >> 3, s = v & 7;
#pragma unroll 1
        for (int i = 0; i < 4; ++i) { const int cur = (i == 0) ? s : (i == 1) ? 15 - s : (i == 2) ? 16 + s : 31 - s; nsa_unit<8>(bg >> 1, bg & 1, cur, T, lds); }
    }
}
#undef NSA_SBAR
#undef NSA_WAIT_BAR
}
struct Frame {
    LAS unsigned char* lds;
    volatile LAS unsigned* MISC;
    gu32* ctl;
    int tid, lane, wave, vcu, G;
};

__device__ __forceinline__ void p0_transpose_item(const float* W, int K, int Nsrc, bf16* WT, LAS float* scr, int kb, int nb, int lane) {
    const int k0 = 64 * kb, n0 = 32 * nb; const int nn = n0 + (lane & 31); const bool ok = nn < Nsrc;
#pragma unroll 8
    for (int i = 0; i < 32; ++i) { const int kk = 2 * i + (lane >> 5); scr[kk * 33 + (lane & 31)] = ok ? W[(size_t)(k0 + kk) * Nsrc + nn] : 0.f; }
    LDS_WAIT(); asm volatile("" ::: "memory");
    const int c = lane & 7;
#pragma unroll
    for (int j = 0; j < 4; ++j) { const int n = (lane >> 3) + 8 * j; const LAS float* s = scr + (8 * c) * 33 + n;
        v4u o; o.x = pk2(s[0 * 33], s[1 * 33]); o.y = pk2(s[2 * 33], s[3 * 33]); o.z = pk2(s[4 * 33], s[5 * 33]); o.w = pk2(s[6 * 33], s[7 * 33]);
        *(GAS v4u*)(WT + (size_t)(n0 + n) * K + k0 + 8 * c) = o; }
    LDS_WAIT(); asm volatile("" ::: "memory");
}
__device__ __forceinline__ void rms_row_to_bf16(const float* xrow, const float* w, bf16* orow, int lane) {
    const GAS f32x4* xr = (const GAS f32x4*)xrow + lane; const GAS f32x4* wr = (const GAS f32x4*)w + lane;
    f32x4 v[4]; float s = 0.f;
#pragma unroll
    for (int j = 0; j < 4; ++j) { v[j] = xr[64 * j]; s += (v[j].x * v[j].x + v[j].y * v[j].y) + (v[j].z * v[j].z + v[j].w * v[j].w); }
    const float rstd = rsqrtf(wave_sum(s) * (1.f / DM) + EPS);
    GAS unsigned long long* o8 = (GAS unsigned long long*)orow + lane;
#pragma unroll
    for (int j = 0; j < 4; ++j) { const f32x4 ww = wr[64 * j]; o8[64 * j] = (unsigned long long)pk2(v[j].x * rstd * ww.x, v[j].y * rstd * ww.y) | ((unsigned long long)pk2(v[j].z * rstd * ww.z, v[j].w * rstd * ww.w) << 32); }
}

struct Args { const float* in[18]; float* out; unsigned char* ws; int ph_lo, ph_hi, li, pad; };

__device__ __forceinline__ void p0_prologue(Frame& F, const Args& args) {
    LAS float* scr = (LAS float*)(F.lds + RING_OFF + F.wave * 16384);
    unsigned char* ws = args.ws;
    const int gw = F.vcu * NWAVES + F.wave, NGW = F.G * NWAVES;
    constexpr int I_IN = (DM / 64) * (NP / 32);
    constexpr int I_O = (DM / 64) * (DM / 32);
    constexpr int I_1 = (2048 / 64) * (256 / 32);
    constexpr int I_2 = (256 / 64) * (64 / 32);
    constexpr int I_G = 8 * 2;
    constexpr int I_B = 2 * 32;
    constexpr int NITEMS = I_IN + I_O + 2 * I_1 + 2 * I_2 + 2 * I_G + I_B;
    for (int it = gw; it < NITEMS; it += NGW) {
        int r = it;
        if (r < I_IN) { p0_transpose_item(args.in[2], DM, DIN, (bf16*)(ws + WS_WIN), scr, r / (NP / 32), r % (NP / 32), F.lane); continue; } r -= I_IN;
        if (r < I_O) { p0_transpose_item(args.in[16], DM, DM, (bf16*)(ws + WS_WO), scr, r / (DM / 32), r % (DM / 32), F.lane); continue; } r -= I_O;
        if (r < I_1) { p0_transpose_item(args.in[11], 2048, 256, (bf16*)(ws + WS_W1K), scr, r / 8, r % 8, F.lane); continue; } r -= I_1;
        if (r < I_1) { p0_transpose_item(args.in[14], 2048, 256, (bf16*)(ws + WS_W1V), scr, r / 8, r % 8, F.lane); continue; } r -= I_1;
        if (r < I_2) { p0_transpose_item(args.in[12], 256, 64, (bf16*)(ws + WS_W2K), scr, r / 2, r % 2, F.lane); continue; } r -= I_2;
        if (r < I_2) { p0_transpose_item(args.in[15], 256, 64, (bf16*)(ws + WS_W2V), scr, r / 2, r % 2, F.lane); continue; } r -= I_2;
        if (r < I_G) { const int h = r >> 1; p0_transpose_item(args.in[5] + h * 4096, 64, 64, (bf16*)(ws + WS_WA) + h * 4096, scr, 0, r & 1, F.lane); continue; } r -= I_G;
        if (r < I_G) { const int h = r >> 1; p0_transpose_item(args.in[7] + h * 4096, 64, 64, (bf16*)(ws + WS_WX) + h * 4096, scr, 0, r & 1, F.lane); continue; } r -= I_G;
        {
            const int mt = r >> 5, kc = r & 31; const float* pe = args.in[mt ? 13 : 10] + kc * 64; const float* w1 = args.in[mt ? 14 : 11] + (size_t)kc * 64 * 256;
            f32x4 a = {0.f, 0.f, 0.f, 0.f};
#pragma unroll 8
            for (int k = 0; k < 64; ++k) { const float p = pe[k]; const f32x4 w = *(const GAS f32x4*)(w1 + (size_t)k * 256 + 4 * F.lane); a += w * p; }
            *(GAS f32x4*)((float*)(ws + WS_B1P) + (size_t)(mt * 32 + kc) * 256 + 4 * F.lane) = a;
        }
    }
    for (int m = gw; m < M; m += NGW) rms_row_to_bf16(args.in[0] + (size_t)m * DM, args.in[1], (bf16*)(ws + WS_XN) + (size_t)m * DM, F.lane);
}

__device__ __forceinline__ void p5_final_norm(Frame& F, const Args& args) {
    const int gw = F.vcu * NWAVES + F.wave, NGW = F.G * NWAVES;
    const float* ssq = (const float*)(args.ws + WS_SSQ); const GAS f32x4* wr = (const GAS f32x4*)args.in[17] + F.lane;
    for (int m = gw; m < M; m += NGW) {
        float s = (F.lane < 16) ? ssq[(size_t)m * 16 + F.lane] : 0.f;
        s += __shfl_xor(s, 1); s += __shfl_xor(s, 2); s += __shfl_xor(s, 4); s += __shfl_xor(s, 8);
        s = __shfl(s, 0);
        const float rstd = rsqrtf(s * (1.f / DM) + EPS);
        GAS f32x4* yr = (GAS f32x4*)(args.out + (size_t)m * DM) + F.lane;
#pragma unroll
        for (int j = 0; j < 4; ++j) { f32x4 v = yr[64 * j]; const f32x4 ww = wr[64 * j]; v = v * rstd * ww; yr[64 * j] = v; }
    }
}

__global__ void __launch_bounds__(NWAVES * 64, 2) mk_fwd(Args args) {
    extern __shared__ __attribute__((aligned(16))) unsigned char lds[];
    Frame F;
    F.lds = (LAS unsigned char*)lds;
    F.MISC = (volatile LAS unsigned*)(F.lds + MISC_OFF);
    F.tid = threadIdx.x; F.lane = F.tid & 63; F.wave = __builtin_amdgcn_readfirstlane(F.tid >> 6);
    F.G = gridDim.x; { const int bx = blockIdx.x; F.vcu = (F.G % 8 == 0) ? (bx % 8) * (F.G / 8) + bx / 8 : bx; }
    unsigned char* ws = args.ws;
    F.ctl = (gu32*)(ws + WS_CTL);
    for (int u = F.tid; u < (LDS_BYTES - LDSCTL_OFF) / 4; u += NWAVES * 64) ((LAS unsigned*)(F.lds + LDSCTL_OFF))[u] = 0u;
    __syncthreads();
    XcdBarrier bar = xcd_barrier_post((unsigned*)(F.ctl + CW_BAR) + args.li * XCD_BAR_WORDS, F.MISC + 8);
    const int lo = args.ph_lo, hi = args.ph_hi;
#define IN(k) (lo <= (k) && (k) < hi)
#define BOTH(k) (IN(k) && IN((k) + 1))
    if (IN(0)) { p0_prologue(F, args); if (BOTH(0)) xcd_barrier(bar); }
    if (IN(1)) {
        if (blockIdx.x == 0) {
            const float* part = (const float*)(ws + WS_B1P); const int mt = F.tid >> 8, n = F.tid & 255; float s = 0.f;
            for (int kc = 0; kc < 32; ++kc) s += part[(size_t)(mt * 32 + kc) * 256 + n];
            ((float*)(ws + WS_B1))[F.tid] = s;
        }
        pg8::Gemm g{(const bf16*)(ws + WS_XN), (const bf16*)(ws + WS_WIN), M, NP, DM}; pg8::StaticOrder S; S.init(M, NP, F.G, (int)blockIdx.x);
        pg8::EpiProj E{(bf16*)(ws + WS_PROJ), NP, QSCALE};
        pg8::gemm_phase<pg8::EpiProj, pg8::StaticOrder, true, true>(F.lds + RING_OFF, g, S, E);
        if (BOTH(1)) xcd_barrier(bar);
    }
    if (IN(3)) {
        nsa::Tensors T{(const bf16*)(ws + WS_PROJ), (const bf16*)(ws + WS_KC), (const bf16*)(ws + WS_VC), (bf16*)(ws + WS_MIX)};
        nsa::nsa_phase(F.lds + RING_OFF, T, F.vcu, F.G);
        if (BOTH(3)) xcd_barrier(bar);
    }
    if (IN(4)) {
        pg8::Gemm g{(const bf16*)(ws + WS_MIX), (const bf16*)(ws + WS_WO), M, DM, DM}; pg8::StaticOrder S; S.init(M, DM, F.G, (int)blockIdx.x);
        pg8::EpiResid E{args.in[0], args.out, (float*)(ws + WS_SSQ), DM};
        pg8::gemm_phase<pg8::EpiResid, pg8::StaticOrder, true, true>(F.lds + RING_OFF, g, S, E);
        if (BOTH(4)) xcd_barrier(bar);
    }
    if (IN(5)) { p5_final_norm(F, args); }
#undef IN
#undef BOTH
}
namespace simple {
constexpr int S = SEQ;
__global__ void __launch_bounds__(512) k_rnn_gates(const bf16* __restrict__ proj, const float* __restrict__ conv_w, const float* __restrict__ conv_b,
                                                    const float* __restrict__ wa, const float* __restrict__ ba, const float* __restrict__ wx, const float* __restrict__ bx,
                                                    const float* __restrict__ lam, float* __restrict__ a_out, float* __restrict__ u_out) {
  __shared__ float xin[512];
  const int row = blockIdx.x, t = row % S, c = threadIdx.x;
  float v = conv_b[c];
#pragma unroll
  for (int k = 0; k < 4; ++k) { const int tt = t - 3 + k; if (tt >= 0) v += conv_w[k * 512 + c] * bf2f(proj[(size_t)(row - 3 + k) * NP + C_RX + c]); }
  xin[c] = v;
  __syncthreads();
  const int h = c >> 6, j = c & 63;
  float sa = 0.f, sx = 0.f;
  for (int i = 0; i < 64; ++i) { const float xi = xin[h * 64 + i]; sa = fmaf(xi, wa[(h * 64 + i) * 64 + j], sa); sx = fmaf(xi, wx[(h * 64 + i) * 64 + j], sx); }
  const float r = 1.0f / (1.0f + expf(-(sa + ba[c])));
  const float ig = 1.0f / (1.0f + expf(-(sx + bx[c])));
  const float L = lam[c];
  const float ls = -log1pf(expf(-L));
  const float log_a = 8.0f * r * ls;
  const float a = expf(log_a);
  const float u = sqrtf(-expm1f(2.0f * log_a)) * (ig * v);
  a_out[(size_t)row * 512 + c] = a;
  u_out[(size_t)row * 512 + c] = u;
}
__global__ void __launch_bounds__(64) k_rnn_scan(const float* __restrict__ a_in, const float* __restrict__ u_in, const bf16* __restrict__ proj, bf16* __restrict__ mix) {
  const int idx = blockIdx.x * 64 + threadIdx.x;
  const int b = idx / 512, c = idx % 512;
  float h = 0.f;
  for (int t = 0; t < S; ++t) {
    const size_t row = (size_t)b * S + t;
    h = fmaf(a_in[row * 512 + c], h, u_in[row * 512 + c]);
    const float g = bf2f(proj[row * NP + C_RG + c]);
    mix[row * DM + c] = (bf16)f2bf(h * (g / (1.0f + expf(-g))));
  }
}
__global__ void __launch_bounds__(256) k_compress(const bf16* __restrict__ proj, int col0, const float* __restrict__ pe, const float* __restrict__ w1, const float* __restrict__ w2, bf16* __restrict__ outc) {
  __shared__ float flat[2048];
  __shared__ float hid[256];
  const int g = blockIdx.x & 1, c = (blockIdx.x >> 1) % NC, b = blockIdx.x / (2 * NC);
  for (int e = threadIdx.x; e < 2048; e += 256) { const int l = e >> 6, d = e & 63; flat[e] = bf2f(proj[(size_t)(b * S + 16 * c + l) * NP + col0 + g * 64 + d]) + pe[l * 64 + d]; }
  __syncthreads();
  float s = 0.f;
  for (int k = 0; k < 2048; ++k) s = fmaf(flat[k], w1[(size_t)k * 256 + threadIdx.x], s);
  hid[threadIdx.x] = s / (1.0f + expf(-s));
  __syncthreads();
  if (threadIdx.x < 64) { float o = 0.f; for (int k = 0; k < 256; ++k) o = fmaf(hid[k], w2[k * 64 + threadIdx.x], o); outc[((size_t)(b * 2 + g) * 128 + c) * 64 + threadIdx.x] = (bf16)f2bf(o); if (c == NC - 1) outc[((size_t)(b * 2 + g) * 128 + 127) * 64 + threadIdx.x] = 0; }
}
}
extern "C" void kernel_launch(void* const* d_in, const int* in_sizes, int n_in, void* d_out, int out_size, void* d_ws, size_t ws_size, hipStream_t stream) {
    static int grid = 0;
    if (grid == 0) {
        if (n_in != 18 || in_sizes[0] != M * DM || out_size != M * DM || ws_size < WS_END) { fprintf(stderr, "kernel_launch: unexpected shapes (n_in %d, in0 %d, out %d, ws %zu); nothing launched\n", n_in, n_in > 0 ? in_sizes[0] : -1, out_size, ws_size); grid = -1; return; }
        int dev = 0, cus = 0;
        if (hipGetDevice(&dev) != hipSuccess || hipDeviceGetAttribute(&cus, hipDeviceAttributeMultiprocessorCount, dev) != hipSuccess) { grid = -1; return; }
        if (hipFuncSetAttribute((const void*)mk_fwd, hipFuncAttributeMaxDynamicSharedMemorySize, LDS_BYTES) != hipSuccess) { fprintf(stderr, "kernel_launch: hipFuncSetAttribute failed\n"); grid = -1; return; }
        (void)hipGetLastError();
        grid = cus;
    }
    if (grid < 0) return;
    (void)hipMemsetAsync((char*)d_ws + WS_CTL, 0, CTL_ZERO_BYTES, stream);
    Args a{};
    for (int i = 0; i < 18; ++i) a.in[i] = (const float*)d_in[i];
    a.out = (float*)d_out; a.ws = (unsigned char*)d_ws;
    unsigned char* ws = (unsigned char*)d_ws;
    a.ph_lo = 0; a.ph_hi = 2; a.li = 0;
    hipLaunchKernelGGL(mk_fwd, dim3(grid), dim3(NWAVES * 64), LDS_BYTES, stream, a);
    {
        using namespace simple;
        const bf16* proj = (const bf16*)(ws + WS_PROJ); bf16* mix = (bf16*)(ws + WS_MIX);
        float* abuf = (float*)(ws + WS_T0); float* ubuf = (float*)(ws + WS_T1);
        bf16* kcb = (bf16*)(ws + WS_KC); bf16* vcb = (bf16*)(ws + WS_VC);
        k_rnn_gates<<<M, 512, 0, stream>>>(proj, a.in[3], a.in[4], a.in[5], a.in[6], a.in[7], a.in[8], a.in[9], abuf, ubuf);
        k_rnn_scan<<<BATCH * 512 / 64, 64, 0, stream>>>(abuf, ubuf, proj, mix);
        k_compress<<<BATCH * NC * 2, 256, 0, stream>>>(proj, C_KC, a.in[10], a.in[11], a.in[12], kcb);
        k_compress<<<BATCH * NC * 2, 256, 0, stream>>>(proj, C_VC, a.in[13], a.in[14], a.in[15], vcb);
    }
    a.ph_lo = 3; a.ph_hi = 6; a.li = 1;
    hipLaunchKernelGGL(mk_fwd, dim3(grid), dim3(NWAVES * 64), LDS_BYTES, stream, a);
}
```

```cpp
#include <hip/hip_runtime.h>
#include <cstdio>
#include <cstdint>
#include <cmath>
namespace pg8 {
#define PG8_LAS __attribute__((address_space(3)))
typedef unsigned short bf16_t;
typedef short bf16x8 __attribute__((ext_vector_type(8)));
typedef float f32x4 __attribute__((ext_vector_type(4)));
typedef unsigned u32x4 __attribute__((ext_vector_type(4)));
constexpr int BM = 256, BK = 64, HALF = 128, HTB = HALF * BK * 2  , STAGE_BYTES = 8 * HTB, NXCD = 8, WGM = 8;

__host__ __device__ __forceinline__ int lds_byte(int r, int c) { const int st = (r >> 4) * 2 + (c >> 5), rr = r & 15, cc = c & 31, ob = rr * 64 + cc * 2; return st * 1024 + (ob ^ (((ob >> 9) & 1) << 5)); }
__host__ __device__ __forceinline__ void stage_rc(int b, int& R, int& C) { const int st = b / 1024, sb = b % 1024, swz = sb ^ (((sb >> 9) & 1) << 5); R = (st >> 1) * 16 + swz / 64; C = (st & 1) * 32 + (swz % 64) / 2; }
__host__ __device__ __forceinline__ int perm32(int rho) { const int n = rho >> 4, i = rho & 15; return 8 * (i >> 2) + 4 * n + (i & 3); }

struct Unit { int pm, pn; };
struct Gemm { const bf16_t* A; const bf16_t* Bt; int M, N, K; };

struct StaticOrder {
    int nM, nN, nwg, G, c;
    __host__ __device__ void init(int M, int N, int G_, int c_) { nM = M / BM; nN = N / BM; nwg = nM * nN; G = G_; c = c_; }
    __host__ __device__ bool next(int i, Unit& u) const {
        const long L = (long)i * G + c; if (L >= nwg) return false;
        int wgid = (int)L; { const int q = nwg / NXCD, r = nwg % NXCD, xcd = wgid % NXCD, off = wgid / NXCD; wgid = (xcd < r ? xcd * (q + 1) : r * (q + 1) + (xcd - r) * q) + off; }
        const int nig = WGM * nN, gid = wgid / nig, fm = gid * WGM, gsz = (nM - fm) < WGM ? (nM - fm) : WGM;
        u.pm = fm + ((wgid % nig) % gsz); u.pn = (wgid % nig) / gsz; return true;
    }
    __device__ __forceinline__ void a_ready(const Unit&) const {}
    __device__ __forceinline__ void done(const Unit&) const {}
};

__device__ __forceinline__ unsigned cvt_pk_bf16(float lo, float hi) { unsigned r; asm volatile("v_cvt_pk_bf16_f32 %0, %1, %2" : "=v"(r) : "v"(lo), "v"(hi)); return r; }
typedef float f32x2 __attribute__((ext_vector_type(2)));
__device__ __forceinline__ f32x2 gelu_pk(f32x2 v) {
    const f32x2 av = __builtin_elementwise_abs(v), d = av * 0.2316418882f + 1.0f;
    f32x2 t; t.x = __builtin_amdgcn_rcpf(d.x); t.y = __builtin_amdgcn_rcpf(d.y);
    f32x2 q = t * 0.5307027145f + (-0.7265760135f); q = q * t + 0.7107068705f; q = q * t + (-0.142248368f); q = q * t + 0.127414796f; q = q * t;
    const f32x2 s = (v * v) * (-0.72134752044f);
    f32x2 e; e.x = __builtin_amdgcn_exp2f(s.x); e.y = __builtin_amdgcn_exp2f(s.y);
    const f32x2 m = v * (q * e), r = v - m;
    f32x2 o; o.x = v.x < 0.f ? m.x : r.x; o.y = v.y < 0.f ? m.y : r.y; return o;
}

template <int ACT  > struct EpiBf16 {
    static constexpr bool PERM = true, AFTER_DRAIN = false; static_assert(ACT == 0 || ACT == 1, "EpiBf16: ACT is 0 (none) or 1 (gelu_pk)");
    bf16_t* O; int ldc; const float* bias; int split_cols; size_t split_stride; float scale0;
    __device__ __forceinline__ void operator()(const f32x4 (&acc)[2][2][4][2], const Unit& u, int wr, int wc, int fr, int fq) const {
        const int row0 = u.pm * BM + wr * 64 + fr; int colt = u.pn * BM; bf16_t* base = O;
        float sc = 1.f; if (split_cols) { const int t = colt / split_cols; base += (size_t)t * split_stride; colt -= t * split_cols; if (t == 0) sc = scale0; }
        const int col0 = colt + wc * 32 + 8 * fq, bcol0 = u.pn * BM + wc * 32 + 8 * fq;
        f32x4 bv[2][2];
#pragma unroll
        for (int bj = 0; bj < 2; ++bj)
#pragma unroll
            for (int n = 0; n < 2; ++n) bv[bj][n] = bias ? *(const f32x4*)(bias + bcol0 + bj * HALF + 4 * n) : (f32x4){0.f, 0.f, 0.f, 0.f};
#pragma unroll
        for (int ai = 0; ai < 2; ++ai)
#pragma unroll
            for (int m = 0; m < 4; ++m) { bf16_t* rowp = base + (size_t)(row0 + ai * HALF + m * 16) * ldc + col0;
#pragma unroll
                for (int bj = 0; bj < 2; ++bj) { f32x4 v0 = acc[ai][bj][m][0] + bv[bj][0], v1 = acc[ai][bj][m][1] + bv[bj][1];
                    if (ACT == 1) { f32x2 a = gelu_pk((f32x2){v0[0], v0[1]}), b = gelu_pk((f32x2){v0[2], v0[3]}), c = gelu_pk((f32x2){v1[0], v1[1]}), d = gelu_pk((f32x2){v1[2], v1[3]});
                        v0 = (f32x4){a.x, a.y, b.x, b.y}; v1 = (f32x4){c.x, c.y, d.x, d.y}; }
                    v0 = v0 * sc; v1 = v1 * sc; u32x4 w; w.x = cvt_pk_bf16(v0[0], v0[1]); w.y = cvt_pk_bf16(v0[2], v0[3]); w.z = cvt_pk_bf16(v1[0], v1[1]); w.w = cvt_pk_bf16(v1[2], v1[3]);
                    *(u32x4*)(rowp + bj * HALF) = w; } }
    }
};
struct EpiProj {
    static constexpr bool PERM = true, AFTER_DRAIN = false;
    bf16_t* O; int ldc; float qscale;
    __device__ __forceinline__ void operator()(const f32x4 (&acc)[2][2][4][2], const Unit& u, int wr, int wc, int fr, int fq) const {
        const int row0 = u.pm * BM + wr * 64 + fr; const int colt = u.pn * BM;
        const float sc = (u.pn == 4 || u.pn == 5) ? qscale : 1.f;
        const int col0 = colt + wc * 32 + 8 * fq;
#pragma unroll
        for (int ai = 0; ai < 2; ++ai)
#pragma unroll
            for (int m = 0; m < 4; ++m) { bf16_t* rowp = O + (size_t)(row0 + ai * HALF + m * 16) * ldc + col0;
#pragma unroll
                for (int bj = 0; bj < 2; ++bj) { f32x4 v0 = acc[ai][bj][m][0] * sc, v1 = acc[ai][bj][m][1] * sc;
                    u32x4 w; w.x = cvt_pk_bf16(v0[0], v0[1]); w.y = cvt_pk_bf16(v0[2], v0[3]); w.z = cvt_pk_bf16(v1[0], v1[1]); w.w = cvt_pk_bf16(v1[2], v1[3]);
                    *(u32x4*)(rowp + bj * HALF) = w; } }
    }
};
struct EpiResid {
    static constexpr bool PERM = false, AFTER_DRAIN = false;
    const float* base; float* out; float* ssq; int ldc;
    __device__ __forceinline__ void operator()(const f32x4 (&acc)[2][2][4][2], const Unit& u, int wr, int wc, int fr, int fq) const {
        const int col0 = u.pn * BM + wc * 32 + 4 * fq;
#pragma unroll
        for (int ai = 0; ai < 2; ++ai)
#pragma unroll
            for (int m = 0; m < 4; ++m) { const int row = u.pm * BM + ai * HALF + wr * 64 + m * 16 + fr; const size_t off = (size_t)row * ldc + col0; float q = 0.f;
#pragma unroll
                for (int bj = 0; bj < 2; ++bj)
#pragma unroll
                    for (int n = 0; n < 2; ++n) { const f32x4 v = acc[ai][bj][m][n] + *(const f32x4*)(base + off + bj * HALF + n * 16);
                        *(f32x4*)(out + off + bj * HALF + n * 16) = v; q += (v[0] * v[0] + v[1] * v[1]) + (v[2] * v[2] + v[3] * v[3]); }
                q += __shfl_xor(q, 16); q += __shfl_xor(q, 32);
                if (fq == 0) ssq[(size_t)row * 16 + u.pn * 4 + wc] = q; }
    }
};
template <class Epi, class Sched, bool ALIGN_EPI = false, bool SP2 = false>
__device__ __forceinline__ void gemm_phase(PG8_LAS unsigned char* lds, const Gemm g, const Sched& S, const Epi& E) {
    const int tid = threadIdx.x, wid = __builtin_amdgcn_readfirstlane(tid >> 6), lane = tid & 63, wr = wid >> 2, wc = wid & 3, fr = lane & 15, fq = lane >> 4;
    const int K = g.K, nt = K / BK;
    unsigned voffA[2], voffB[2];
#pragma unroll
    for (int i = 0; i < 2; ++i) { int R, C; stage_rc(tid * 16 + i * 8192, R, C); const int Rb = Epi::PERM ? ((R & ~31) + perm32(R & 31)) : R;
        voffA[i] = (unsigned)(R * K + C) * 2u; voffB[i] = (unsigned)(Rb * K + C) * 2u; }
    const size_t kstep = (size_t)(BK * 2);
    const size_t hstep = (size_t)HALF * K * 2;
    const size_t tstep = 2 * hstep;
    const unsigned ldsw = (unsigned)wid * 1024u;
    const int aoff = lds_byte(wr * 64 + fr, fq * 8), boff = lds_byte(wc * 32 + fr, fq * 8);
#define PG8_SA(b, h) (((b) * 2 + (h)) * HTB)
#define PG8_SB(b, h) ((4 + (b) * 2 + (h)) * HTB)
#define PG8_STAGE(bufoff, gbase, voff) do { _Pragma("unroll") for (int _i = 0; _i < 2; ++_i) \
        __builtin_amdgcn_global_load_lds((const unsigned*)((const char*)(gbase) + (voff)[_i]), (PG8_LAS unsigned*)(lds + (bufoff) + ldsw + _i * 8192), 16, 0, 0); } while (0)
#define PG8_LDA(dst, b, h) do { _Pragma("unroll") for (int m = 0; m < 4; ++m) _Pragma("unroll") for (int k = 0; k < 2; ++k) dst[m][k] = *(const PG8_LAS bf16x8*)(lds + PG8_SA(b, h) + aoff + m * 2048 + k * 1024); } while (0)
#define PG8_LDB(dst, b, h) do { _Pragma("unroll") for (int n = 0; n < 2; ++n) _Pragma("unroll") for (int k = 0; k < 2; ++k) dst[n][k] = *(const PG8_LAS bf16x8*)(lds + PG8_SB(b, h) + boff + n * 2048 + k * 1024); } while (0)
#define PG8_MMA(ai, bj, At, Bt) do { __builtin_amdgcn_s_setprio(1); _Pragma("unroll") for (int m = 0; m < 4; ++m) _Pragma("unroll") for (int n = 0; n < 2; ++n) _Pragma("unroll") for (int k = 0; k < 2; ++k) \
        acc[ai][bj][m][n] = __builtin_amdgcn_mfma_f32_16x16x32_bf16(Bt[n][k], At[m][k], acc[ai][bj][m][n], 0, 0, 0); __builtin_amdgcn_s_setprio(0); } while (0)
#define PG8_WAIT_V(n) asm volatile("s_waitcnt vmcnt(" #n ")" ::: "memory")
#define PG8_WAIT_L(n) asm volatile("s_waitcnt lgkmcnt(" #n ")" ::: "memory")
#define PG8_BAR __builtin_amdgcn_s_barrier()
#define PG8_SCHED __builtin_amdgcn_sched_barrier(0)
    Unit cur, nxt; int ui = 0;
    if (!S.next(0, cur)) return;
    f32x4 acc[2][2][4][2];
#pragma unroll
    for (int a = 0; a < 2; ++a)
#pragma unroll
        for (int b = 0; b < 2; ++b)
#pragma unroll
            for (int m = 0; m < 4; ++m)
#pragma unroll
                for (int n = 0; n < 2; ++n) acc[a][b][m][n] = (f32x4){0.f, 0.f, 0.f, 0.f};
    bf16x8 At[4][2], B0[2][2], B1[2][2];
    const char* cA = (const char*)g.A + (size_t)cur.pm * tstep; const char* cB = (const char*)g.Bt + (size_t)cur.pn * tstep;
    S.a_ready(cur);
    if constexpr (SP2) {
        PG8_STAGE(PG8_SB(0, 0), cB, voffB); PG8_STAGE(PG8_SB(0, 1), cB + hstep, voffB); PG8_STAGE(PG8_SA(0, 0), cA, voffA); PG8_STAGE(PG8_SA(0, 1), cA + hstep, voffA);
        if (wr == 1) PG8_BAR;
        PG8_WAIT_V(2); PG8_BAR;
        PG8_STAGE(PG8_SB(1, 0), cB + kstep, voffB); PG8_STAGE(PG8_SA(1, 0), cA + kstep, voffA); PG8_STAGE(PG8_SB(1, 1), cB + hstep + kstep, voffB);
        PG8_WAIT_V(6); PG8_BAR;
    } else {
        PG8_STAGE(PG8_SB(0, 0), cB, voffB); PG8_STAGE(PG8_SA(0, 0), cA, voffA); PG8_STAGE(PG8_SB(0, 1), cB + hstep, voffB); PG8_STAGE(PG8_SA(0, 1), cA + hstep, voffA);
        if (wr == 1) PG8_BAR;
        PG8_WAIT_V(4); PG8_BAR;
        PG8_STAGE(PG8_SB(1, 0), cB + kstep, voffB); PG8_STAGE(PG8_SA(1, 0), cA + kstep, voffA); PG8_STAGE(PG8_SB(1, 1), cB + hstep + kstep, voffB);
        PG8_WAIT_V(6); PG8_BAR;
    }
    for (;;) {
        const bool has_next = S.next(ui + 1, nxt);
        const char* nA = has_next ? (const char*)g.A + (size_t)nxt.pm * tstep : cA; const char* nB = has_next ? (const char*)g.Bt + (size_t)nxt.pn * tstep : cB;
        for (int t = 0; t < nt; t += 2) {
            const bool last = (t == nt - 2);
            const char* a1 = cA + (size_t)(t + 1) * kstep;
            const char* a2 = last ? nA : cA + (size_t)(t + 2) * kstep; const char* b2 = last ? nB : cB + (size_t)(t + 2) * kstep;
            const char* a3 = a2 + kstep; const char* b3 = b2 + kstep;
            if (last && has_next) S.a_ready(nxt);
            if constexpr (SP2) {
            PG8_LDB(B0, 0, 0); PG8_LDB(B1, 0, 1); PG8_SCHED; PG8_LDA(At, 0, 0); PG8_STAGE(PG8_SA(1, 1), a1 + hstep, voffA);
            PG8_WAIT_V(8); PG8_WAIT_L(0); PG8_BAR; PG8_MMA(0, 0, At, B0); PG8_MMA(0, 1, At, B1); PG8_BAR; PG8_SCHED;
            PG8_LDA(At, 0, 1); PG8_STAGE(PG8_SB(0, 0), b2, voffB); PG8_STAGE(PG8_SB(0, 1), b2 + hstep, voffB); PG8_STAGE(PG8_SA(0, 0), a2, voffA);
            PG8_WAIT_V(8); PG8_WAIT_L(0); PG8_BAR; PG8_MMA(1, 0, At, B0); PG8_MMA(1, 1, At, B1); PG8_BAR; PG8_SCHED;
            PG8_LDB(B0, 1, 0); PG8_LDB(B1, 1, 1); PG8_SCHED; PG8_LDA(At, 1, 0); PG8_STAGE(PG8_SA(0, 1), a2 + hstep, voffA);
            PG8_WAIT_V(8); PG8_WAIT_L(0); PG8_BAR; PG8_MMA(0, 0, At, B0); PG8_MMA(0, 1, At, B1); PG8_BAR; PG8_SCHED;
            PG8_LDA(At, 1, 1); PG8_STAGE(PG8_SB(1, 0), b3, voffB); PG8_STAGE(PG8_SB(1, 1), b3 + hstep, voffB); PG8_STAGE(PG8_SA(1, 0), a3, voffA);
            PG8_WAIT_V(8); PG8_WAIT_L(0); PG8_BAR; PG8_MMA(1, 0, At, B0); PG8_MMA(1, 1, At, B1); PG8_BAR; PG8_SCHED;
            } else {
            PG8_LDB(B0, 0, 0); PG8_SCHED; PG8_LDA(At, 0, 0); PG8_STAGE(PG8_SA(1, 1), a1 + hstep, voffA);
            PG8_WAIT_L(8); PG8_BAR; PG8_WAIT_L(0); PG8_MMA(0, 0, At, B0); PG8_BAR; PG8_SCHED;
            PG8_LDB(B1, 0, 1); PG8_STAGE(PG8_SB(0, 0), b2, voffB);
            PG8_BAR; PG8_WAIT_L(0); PG8_MMA(0, 1, At, B1); PG8_BAR;
            PG8_LDA(At, 0, 1); PG8_STAGE(PG8_SA(0, 0), a2, voffA);
            PG8_BAR; PG8_WAIT_L(0); PG8_MMA(1, 0, At, B0); PG8_BAR; PG8_SCHED;
            PG8_STAGE(PG8_SB(0, 1), b2 + hstep, voffB);
            PG8_WAIT_V(6); PG8_BAR; PG8_MMA(1, 1, At, B1); PG8_BAR;
            PG8_LDB(B0, 1, 0); PG8_SCHED; PG8_LDA(At, 1, 0); PG8_STAGE(PG8_SA(0, 1), a2 + hstep, voffA);
            PG8_WAIT_L(8); PG8_BAR; PG8_WAIT_L(0); PG8_MMA(0, 0, At, B0); PG8_BAR; PG8_SCHED;
            PG8_LDB(B1, 1, 1); PG8_STAGE(PG8_SB(1, 0), b3, voffB);
            PG8_BAR; PG8_WAIT_L(0); PG8_MMA(0, 1, At, B1); PG8_BAR;
            PG8_LDA(At, 1, 1); PG8_STAGE(PG8_SA(1, 0), a3, voffA);
            PG8_BAR; PG8_WAIT_L(0); PG8_MMA(1, 0, At, B0); PG8_BAR; PG8_SCHED;
            PG8_STAGE(PG8_SB(1, 1), b3 + hstep, voffB);
            PG8_WAIT_V(6); PG8_BAR; PG8_MMA(1, 1, At, B1); PG8_BAR;
            }
        }
        if constexpr (ALIGN_EPI) { if (wr == 0) PG8_BAR; }
        if constexpr (!Epi::AFTER_DRAIN) { E(acc, cur, wr, wc, fr, fq); S.done(cur); }
        if (!has_next) break;
#pragma unroll
        for (int a = 0; a < 2; ++a)
#pragma unroll
            for (int b = 0; b < 2; ++b)
#pragma unroll
                for (int m = 0; m < 4; ++m)
#pragma unroll
                    for (int n = 0; n < 2; ++n) acc[a][b][m][n] = (f32x4){0.f, 0.f, 0.f, 0.f};
        cur = nxt; cA = nA; cB = nB; ++ui;
        if constexpr (ALIGN_EPI) { if (wr == 1) PG8_BAR; }
    }
    PG8_WAIT_V(0);
    if constexpr (!ALIGN_EPI) { if (wr == 0) PG8_BAR; }
    PG8_BAR;
    if constexpr (Epi::AFTER_DRAIN) { E.fused(acc, cur, wr, wc, fr, fq, lds, wid, lane); S.done(cur); }
#undef PG8_SA
#undef PG8_SB
#undef PG8_STAGE
#undef PG8_LDA
#undef PG8_LDB
#undef PG8_MMA
#undef PG8_WAIT_V
#undef PG8_WAIT_L
#undef PG8_BAR
#undef PG8_SCHED
}
}
#define GAS __attribute__((address_space(1)))
#define LAS __attribute__((address_space(3)))
typedef unsigned short bf16;
typedef unsigned v4u __attribute__((ext_vector_type(4)));
typedef float f32x4 __attribute__((ext_vector_type(4)));
typedef short bf16x8 __attribute__((ext_vector_type(8)));
typedef GAS unsigned gu32;
typedef GAS unsigned long long gu64;
#define RLX_AGENT __ATOMIC_RELAXED, __HIP_MEMORY_SCOPE_AGENT
#define LDS_WAIT() asm volatile("s_waitcnt lgkmcnt(0)" ::: "memory")
#define VM_WAIT() asm volatile("s_waitcnt vmcnt(0)" ::: "memory")
__device__ __forceinline__ unsigned long long rt() { return __builtin_amdgcn_s_memrealtime(); }
__device__ __forceinline__ unsigned f2bf(float f) { unsigned u = __builtin_bit_cast(unsigned, f); return (u + 0x7fffu + ((u >> 16) & 1u)) >> 16; }
__device__ __forceinline__ unsigned pk2(float lo, float hi) { return f2bf(lo) | (f2bf(hi) << 16); }

#define XB_TMO      128
#define XB_XCNT(j)  (256  + 64 * (j))
#define XB_XSUB(j)  (1280 + 64 * (j))
#define XB_XGEN(j)  (2304 + 64 * (j))
#define XB_TOP      3328
#define XB_TOPGEN   3392
#define XCD_BAR_WORDS 3456
#define XB_SPIN_CAP (1u << 18)

__device__ __forceinline__ unsigned xb_ld(unsigned* p)              { return __hip_atomic_load(p, __ATOMIC_RELAXED, __HIP_MEMORY_SCOPE_AGENT); }
__device__ __forceinline__ unsigned xb_add(unsigned* p, unsigned v) { return __hip_atomic_fetch_add(p, v, __ATOMIC_RELAXED, __HIP_MEMORY_SCOPE_AGENT); }
__device__ __forceinline__ unsigned xb_xcc_id() { return (unsigned)__builtin_amdgcn_s_getreg((3 << 11) | 20) & 0xFu; }
#define XB_SPIN(cond, bar) do { unsigned _sp = 0; while (cond) { __builtin_amdgcn_s_sleep(1); \
    if ((++_sp & 255u) == 0u) { if (xb_ld(&(bar)[XB_TMO])) break; if (_sp > XB_SPIN_CAP) { atomicAdd(&(bar)[XB_TMO], 1u); break; } } } } while (0)

struct XcdBarrier {
    unsigned* bar; unsigned x;
    volatile LAS unsigned* st;
};

__device__ __forceinline__ XcdBarrier xcd_barrier_post(unsigned* bar, volatile LAS unsigned* st) {
    XcdBarrier b; b.bar = bar; b.x = xb_xcc_id(); b.st = st;
    if (threadIdx.x == 0) (void)xb_add(&bar[XB_XCNT(b.x)], 1u);
    return b;
}
__device__ __forceinline__ void xcd_barrier_complete(unsigned* bar, unsigned x, unsigned& nloc, unsigned& nx) {
    const unsigned G = gridDim.x * gridDim.y * gridDim.z;
    unsigned sum, cnt, mine, sp = 0u;
    for (;;) {
        sum = 0u; cnt = 0u; mine = 0u;
#pragma unroll
        for (unsigned j = 0; j < 16; ++j) { const unsigned c = xb_ld(&bar[XB_XCNT(j)]); sum += c; cnt += (c > 0u) ? 1u : 0u; mine = (j == x) ? c : mine; }
        if (sum == G) break;
        __builtin_amdgcn_s_sleep(1);
        if ((++sp & 255u) == 0u) { if (xb_ld(&bar[XB_TMO])) break; if (sp > XB_SPIN_CAP) { atomicAdd(&bar[XB_TMO], 1u); break; } }
    }
    nloc = mine > 0u ? mine : 1u; nx = cnt > 0u ? cnt : 1u;
}

__device__ __forceinline__ void xcd_barrier(const XcdBarrier& b) {
    asm volatile("s_waitcnt vmcnt(0)" ::: "memory");
    __syncthreads();
    if (threadIdx.x == 0) {
        unsigned* bar = b.bar;
        __builtin_amdgcn_s_waitcnt(0);
        unsigned nloc = b.st[0], nx = b.st[1];
        if (nloc == 0u) { xcd_barrier_complete(bar, b.x, nloc, nx); b.st[0] = nloc; b.st[1] = nx; }
        const unsigned old = xb_add(&bar[XB_XSUB(b.x)], 1u);
        const unsigned gen = old / nloc;
        if (old + 1u == (gen + 1u) * nloc) {
            __builtin_amdgcn_fence(__ATOMIC_RELEASE, "agent");
            asm volatile("s_waitcnt vmcnt(0)" ::: "memory");
            const unsigned og = xb_add(&bar[XB_TOP], 1u);
            const unsigned tg = og / nx;
            if (og + 1u == (tg + 1u) * nx) xb_add(&bar[XB_TOPGEN], 1u);
            else XB_SPIN(xb_ld(&bar[XB_TOPGEN]) == tg, bar);
            __builtin_amdgcn_fence(__ATOMIC_ACQUIRE, "agent");
            xb_add(&bar[XB_XGEN(b.x)], 1u);
            asm volatile("s_waitcnt vmcnt(0)" ::: "memory");
        } else {
            XB_SPIN(xb_ld(&bar[XB_XGEN(b.x)]) == gen, bar);
            __builtin_amdgcn_fence(__ATOMIC_ACQUIRE, "agent");
            asm volatile("s_waitcnt vmcnt(0)" ::: "memory");
        }
    }
    __syncthreads();
}
constexpr int NWAVES = 8;
constexpr int BATCH = 16, SEQ = 2048, DM = 1024, M = BATCH * SEQ;
constexpr int DIN = 2840, NP = 3072;
constexpr int C_RX = 0, C_RG = 512, C_Q = 1024, C_KC = 1536, C_VC = 1664, C_KS = 1792, C_VS = 1920, C_KW = 2048, C_VW = 2176, C_AG = 2304, C_BG = 2816;
constexpr int NC = 127, NCP = 128;
constexpr float EPS = 1e-6f;
constexpr float QSCALE = 0.125f * 1.4426950408889634f;

constexpr size_t MiB = 1u << 20, KiB = 1u << 10;
constexpr size_t WS_CTL = 0, CTL_ZERO_BYTES = 1 * MiB;
constexpr size_t WS_WIN = 2 * MiB, WS_WO = 8 * MiB;
constexpr size_t WS_W1K = 10 * MiB, WS_W1V = 11 * MiB, WS_W2K = 12 * MiB, WS_W2V = 12 * MiB + 64 * KiB, WS_WA = 12 * MiB + 128 * KiB, WS_WX = 12 * MiB + 192 * KiB;
constexpr size_t WS_B1P = 12 * MiB + 256 * KiB, WS_B1 = 12 * MiB + 320 * KiB;
constexpr size_t WS_RSUM = 13 * MiB, WS_KC = 14 * MiB, WS_VC = 14 * MiB + 512 * KiB, WS_SSQ = 16 * MiB, WS_HID = 18 * MiB;
constexpr size_t WS_XN = 32 * MiB, WS_PROJ = 96 * MiB, WS_MIX = 288 * MiB, WS_T0 = 352 * MiB, WS_T1 = 416 * MiB, WS_END = 480 * MiB;
constexpr int CW_TMO = 0, CW_CODE = 1, CW_BAR = 4096;

constexpr int RING_OFF = 0, RING_BYTES = 131072;
constexpr int LDSCTL_OFF = RING_BYTES, MISC_OFF = LDSCTL_OFF + 320;
constexpr int LDS_BYTES = 147456;

__device__ __forceinline__ float bf2f(bf16 v) { return __builtin_bit_cast(float, (unsigned)v << 16); }
__device__ __forceinline__ float wave_sum(float v) {
#pragma unroll
    for (int o = 1; o < 64; o <<= 1) v += __shfl_xor(v, o);
    return v;
}
__device__ __forceinline__ float wave_max(float v) {
#pragma unroll
    for (int o = 1; o < 64; o <<= 1) v = fmaxf(v, __shfl_xor(v, o));
    return v;
}
__device__ __forceinline__ float sigmoidf_(float x) { return 1.0f / (1.0f + __expf(-x)); }
__device__ __forceinline__ float siluf_(float x) { return x / (1.0f + __expf(-x)); }

namespace nsa {
using bf16x8 = __attribute__((ext_vector_type(8))) short;
using s16x4 = __attribute__((ext_vector_type(4))) short;
using f32x16 = __attribute__((ext_vector_type(16))) float;
using u32x4 = __attribute__((ext_vector_type(4))) unsigned;
typedef short v4i16_t __attribute__((ext_vector_type(4)));
constexpr int NSLOT = 4, SLOTB = 8192;
constexpr int L_K = 0, L_V = NSLOT * SLOTB, L_WS = 2 * NSLOT * SLOTB, L_OST = L_WS + 8 * 256, L_IMPB = L_OST, L_IMPF = L_OST + 32768, L_SELM = L_IMPF + 8192, L_END = L_SELM + 256;
static_assert(L_END <= RING_BYTES, "nsa LDS map");
#define NSA_SBAR() __builtin_amdgcn_sched_barrier(0)
#define NSA_WAIT_BAR(N) asm volatile("s_waitcnt vmcnt(" #N ") lgkmcnt(0)\n\ts_barrier" ::: "memory")
__device__ __forceinline__ int crow(int r, int hi) { return (r & 3) + 8 * (r >> 2) + 4 * hi; }
__device__ __forceinline__ void glds16(const void* gsrc, unsigned lds_dst) { unsigned keep;
    asm volatile("s_mov_b32 %0, m0\n\ts_mov_b32 m0, %2\n\ts_nop 0\n\tglobal_load_lds_dwordx4 %1, off\n\ts_mov_b32 m0, %0" : "=&s"(keep) : "v"(gsrc), "s"(lds_dst) : "memory"); }
typedef float f32x2_t __attribute__((ext_vector_type(2))); typedef __bf16 bf16x2_t __attribute__((ext_vector_type(2)));
__device__ __forceinline__ unsigned cvtpk(float lo, float hi) { f32x2_t v = {lo, hi}; bf16x2_t b = __builtin_convertvector(v, bf16x2_t); return __builtin_bit_cast(unsigned, b); }
__device__ __forceinline__ float xhalf(float v) { return __shfl_xor(v, 32); }

__device__ __forceinline__ void qkt(f32x16& p0, f32x16& p1, const LAS unsigned char* kslot, const bf16x8* qr, const f32x16& cinit, int r32, int hi) {
    const LAS unsigned char* kb = kslot + hi * 1024 + r32 * 16;
#pragma unroll
    for (int d0 = 0; d0 < 4; ++d0) {
        const bf16x8 b0 = *(const LAS bf16x8*)(kb + d0 * 2048);
        const bf16x8 b1 = *(const LAS bf16x8*)(kb + d0 * 2048 + 512);
        if (d0 == 0) { p0 = __builtin_amdgcn_mfma_f32_32x32x16_bf16(b0, qr[0], cinit, 0, 0, 0); p1 = __builtin_amdgcn_mfma_f32_32x32x16_bf16(b1, qr[0], cinit, 0, 0, 0); }
        else { p0 = __builtin_amdgcn_mfma_f32_32x32x16_bf16(b0, qr[d0], p0, 0, 0, 0); p1 = __builtin_amdgcn_mfma_f32_32x32x16_bf16(b1, qr[d0], p1, 0, 0, 0); }
    }
}
__device__ __forceinline__ s16x4 vtr(const LAS unsigned char* p) { return __builtin_bit_cast(s16x4, __builtin_amdgcn_ds_read_tr16_b64_v4i16((LAS v4i16_t*)p)); }
__device__ __forceinline__ void pv(f32x16* o, const LAS unsigned char* vp, bf16x8 pa0, bf16x8 pa1, bf16x8 pa2, bf16x8 pa3) {
#pragma unroll
    for (int d0 = 0; d0 < 2; ++d0) {
        s16x4 lo[4], hh[4];
#pragma unroll
        for (int ks = 0; ks < 4; ++ks) { lo[ks] = vtr(vp + d0 * 4096 + ks * 1024); hh[ks] = vtr(vp + d0 * 4096 + ks * 1024 + 512); }
#define NSA_PK(k) (bf16x8){lo[k][0], lo[k][1], lo[k][2], lo[k][3], hh[k][0], hh[k][1], hh[k][2], hh[k][3]}
        o[d0] = __builtin_amdgcn_mfma_f32_32x32x16_bf16(pa0, NSA_PK(0), o[d0], 0, 0, 0);
        o[d0] = __builtin_amdgcn_mfma_f32_32x32x16_bf16(pa1, NSA_PK(1), o[d0], 0, 0, 0);
        o[d0] = __builtin_amdgcn_mfma_f32_32x32x16_bf16(pa2, NSA_PK(2), o[d0], 0, 0, 0);
        o[d0] = __builtin_amdgcn_mfma_f32_32x32x16_bf16(pa3, NSA_PK(3), o[d0], 0, 0, 0);
#undef NSA_PK
    }
}
__device__ __forceinline__ float rowmax32(const f32x16& p0, const f32x16& p1) {
    float a = fmaxf(p0[0], p1[0]);
#pragma unroll
    for (int r = 1; r < 16; ++r) a = fmaxf(a, fmaxf(p0[r], p1[r]));
    return a;
}
template <int MODE> __device__ __forceinline__ void edge_mask(f32x16& p0, f32x16& p1, int tq, int hi) {
#pragma unroll
    for (int r = 0; r < 16; ++r) { const int kv = crow(r, hi);
        if (MODE == 1) { if (kv > tq) p0[r] = -INFINITY; if (kv + 32 > tq) p1[r] = -INFINITY; }
        else { if (kv <= tq) p0[r] = -INFINITY; if (kv + 32 <= tq) p1[r] = -INFINITY; } }
}

struct Tensors { const bf16* proj; const bf16* kc; const bf16* vc; bf16* mix; };

template <int THRL>
__device__ __forceinline__ void nsa_unit(int b, int g, int cur, const Tensors& T, LAS unsigned char* shm) {
    const int tid = threadIdx.x, lane = tid & 63, r32 = lane & 31, hi = lane >> 5;
    const int wid = __builtin_amdgcn_readfirstlane(tid >> 6);
    const int hr = wid >> 1, th = wid & 1, hq = g * 4 + hr;
    const int t0 = cur * 64, tq = 32 * th + r32;
    const size_t rowb = (size_t)b * SEQ;
    const unsigned lds0 = (unsigned)(size_t)shm;
    LAS float* wsf = (LAS float*)(shm + L_WS) + wid * 64;
    const int nwin = (cur < 8 ? cur : 8) + 1, wj0 = cur - (nwin - 1);
    const int NT = 2 + (cur + 1) + nwin;
    const bf16* kcg = T.kc + (size_t)(b * 2 + g) * 128 * 64; const bf16* vcg = T.vc + (size_t)(b * 2 + g) * 128 * 64;
    const bf16* pk = T.proj + rowb * NP + g * 64;
#define NSA_ISSUE(i_) do { const int i__ = (i_); if (i__ < NT) { const bf16* kp_; const bf16* vp_; int pitch_; \
        if (i__ < 2) { kp_ = kcg + (size_t)i__ * 64 * 64; vp_ = vcg + (size_t)i__ * 64 * 64; pitch_ = 64; } \
        else if (i__ < 3 + cur) { const int j_ = i__ - 2; kp_ = pk + (size_t)j_ * 64 * NP + C_KS; vp_ = pk + (size_t)j_ * 64 * NP + C_VS; pitch_ = NP; } \
        else { const int j_ = wj0 + (i__ - 3 - cur); kp_ = pk + (size_t)j_ * 64 * NP + C_KW; vp_ = pk + (size_t)j_ * 64 * NP + C_VW; pitch_ = NP; } \
        const unsigned so_ = (unsigned)((i__ & (NSLOT - 1)) * SLOTB) + (unsigned)wid * 1024u; \
        glds16(kp_ + (size_t)lane * pitch_ + wid * 8, (unsigned)__builtin_amdgcn_readfirstlane(lds0 + L_K + so_)); \
        glds16(vp_ + (size_t)(16 * (wid & 3) + (lane >> 2)) * pitch_ + (wid >> 2) * 32 + (lane & 3) * 8, (unsigned)__builtin_amdgcn_readfirstlane(lds0 + L_V + so_)); } } while (0)
    const bf16* qrow = T.proj + (rowb + t0 + tq) * NP;
    bf16x8 qr[4];
#pragma unroll
    for (int d0 = 0; d0 < 4; ++d0) qr[d0] = *(const bf16x8*)(qrow + C_Q + hq * 64 + d0 * 16 + hi * 8);
    const float gt0 = sigmoidf_(bf2f(qrow[C_BG + 0 * 8 + hq])), gt1 = sigmoidf_(bf2f(qrow[C_BG + 1 * 8 + hq])), gt2 = sigmoidf_(bf2f(qrow[C_BG + 2 * 8 + hq]));
    asm volatile("s_waitcnt vmcnt(0)" ::: "memory");
    NSA_ISSUE(0); NSA_ISSUE(1);
    const LAS unsigned char* kbase = shm + L_K;
    const LAS unsigned char* vbase = shm + L_V + ((lane >> 4) & 1) * 32 + (lane & 3) * 8 + (4 * hi + ((lane & 15) >> 2)) * 64;
    f32x16 oc[2]; oc[0] = f32x16{}; oc[1] = f32x16{};
    f32x16 o[2];
    f32x16 zero16 = f32x16{};
    u32x4 pw0, pw1, pw2, pw3;
#define NSA_PACK(P0, P1) do { \
        pw0 = (u32x4){cvtpk(P0[0], P0[1]), cvtpk(P0[2], P0[3]), cvtpk(P0[4], P0[5]), cvtpk(P0[6], P0[7])}; \
        pw1 = (u32x4){cvtpk(P0[8], P0[9]), cvtpk(P0[10], P0[11]), cvtpk(P0[12], P0[13]), cvtpk(P0[14], P0[15])}; \
        pw2 = (u32x4){cvtpk(P1[0], P1[1]), cvtpk(P1[2], P1[3]), cvtpk(P1[4], P1[5]), cvtpk(P1[6], P1[7])}; \
        pw3 = (u32x4){cvtpk(P1[8], P1[9]), cvtpk(P1[10], P1[11]), cvtpk(P1[12], P1[13]), cvtpk(P1[14], P1[15])}; } while (0)
#define NSA_PAF(k) __builtin_bit_cast(bf16x8, pw##k)
#define NSA_ACCUM(FAC) do { if (hi == 0) wsf[r32] = (FAC); asm volatile("s_waitcnt lgkmcnt(0)" ::: "memory"); \
        _Pragma("unroll") for (int r = 0; r < 16; ++r) { const float f_ = wsf[crow(r, hi)]; oc[0][r] += o[0][r] * f_; oc[1][r] += o[1][r] * f_; } \
        asm volatile("s_waitcnt lgkmcnt(0)" ::: "memory"); } while (0)

    NSA_WAIT_BAR(0);
    NSA_ISSUE(2); NSA_ISSUE(3);
    {
        const int t = t0 + tq; const int cmax = (t >= 31) ? ((t - 31) >> 4) : -1;
        const bool two = (cur >= 16);
        f32x16 a0, a1, b0, b1;
        qkt(a0, a1, kbase, qr, zero16, r32, hi);
        if (two) qkt(b0, b1, kbase + SLOTB, qr, zero16, r32, hi); else { b0 = f32x16{}; b1 = f32x16{}; }
#pragma unroll
        for (int r = 0; r < 16; ++r) { const int c = crow(r, hi);
            if (c > cmax) a0[r] = -INFINITY; if (c + 32 > cmax) a1[r] = -INFINITY;
            if (!two || c + 64 > cmax) b0[r] = -INFINITY; if (!two || c + 96 > cmax) b1[r] = -INFINITY; }
        float m = fmaxf(rowmax32(a0, a1), rowmax32(b0, b1)); m = fmaxf(m, xhalf(m));
        if (!(m > -INFINITY)) m = 0.f;
        float l = 0.f;
#pragma unroll
        for (int r = 0; r < 16; ++r) { a0[r] = __builtin_amdgcn_exp2f(a0[r] - m); a1[r] = __builtin_amdgcn_exp2f(a1[r] - m); b0[r] = __builtin_amdgcn_exp2f(b0[r] - m); b1[r] = __builtin_amdgcn_exp2f(b1[r] - m);
            l += (a0[r] + a1[r]) + (b0[r] + b1[r]); }
        l += xhalf(l);
        const float linv = l > 0.f ? 1.0f / l : 1.0f;
        float mainv[16], spill[16];
#pragma unroll
        for (int gi = 0; gi < 4; ++gi) {
            mainv[gi] = (a0[4 * gi] + a0[4 * gi + 1]) + (a0[4 * gi + 2] + 0.5f * a0[4 * gi + 3]); spill[gi] = 0.5f * a0[4 * gi + 3];
            mainv[4 + gi] = (a1[4 * gi] + a1[4 * gi + 1]) + (a1[4 * gi + 2] + 0.5f * a1[4 * gi + 3]); spill[4 + gi] = 0.5f * a1[4 * gi + 3];
            mainv[8 + gi] = (b0[4 * gi] + b0[4 * gi + 1]) + (b0[4 * gi + 2] + 0.5f * b0[4 * gi + 3]); spill[8 + gi] = 0.5f * b0[4 * gi + 3];
            mainv[12 + gi] = (b1[4 * gi] + b1[4 * gi + 1]) + (b1[4 * gi + 2] + 0.5f * b1[4 * gi + 3]); spill[12 + gi] = 0.5f * b1[4 * gi + 3];
        }
        LAS float* impb = (LAS float*)(shm + L_IMPB) + (size_t)(hr * 64 + tq) * 32;
        float other[16];
#pragma unroll
        for (int i = 0; i < 16; ++i) other[i] = xhalf(spill[i]);
#pragma unroll
        for (int i = 0; i < 16; ++i) { const float add = hi ? other[i] : (i > 0 ? other[i > 0 ? i - 1 : 0] : 0.f); impb[2 * i + hi] = (mainv[i] + add) * linv; }
        o[0] = f32x16{}; o[1] = f32x16{};
        NSA_PACK(a0, a1); pv(o, vbase, NSA_PAF(0), NSA_PAF(1), NSA_PAF(2), NSA_PAF(3));
        if (two) { NSA_PACK(b0, b1); pv(o, vbase + SLOTB, NSA_PAF(0), NSA_PAF(1), NSA_PAF(2), NSA_PAF(3)); }
        NSA_ACCUM(gt0 * linv);
    }
    asm volatile("s_waitcnt lgkmcnt(0)\n\ts_barrier" ::: "memory");
    {
        const int tk = tid >> 3, part = tid & 7;
        const LAS float* ib = (const LAS float*)(shm + L_IMPB);
        LAS float* impf = (LAS float*)(shm + L_IMPF) + tk * 32;
        float v[4];
#pragma unroll
        for (int q = 0; q < 4; ++q) { const int j = 4 * part + q;
            float s = ((ib[(0 * 64 + tk) * 32 + j] + ib[(1 * 64 + tk) * 32 + j]) + ib[(2 * 64 + tk) * 32 + j]) + ib[(3 * 64 + tk) * 32 + j];
            if (j == 0 || j == cur || j == cur - 1) s = 1e9f;
            if (j > cur) s = -1e9f;
            v[q] = s; impf[j] = s; }
        asm volatile("s_waitcnt lgkmcnt(0)\n\ts_barrier" ::: "memory");
        unsigned bits = 0u;
#pragma unroll
        for (int q = 0; q < 4; ++q) { const int j = 4 * part + q; int rank = 0;
#pragma unroll 8
            for (int jj = 0; jj < 32; ++jj) { const float w = impf[jj]; rank += (w > v[q] || (w == v[q] && jj < j)) ? 1 : 0; }
            if (rank < 8 && v[q] > -0.5e9f) bits |= 1u << j; }
        bits |= __shfl_xor(bits, 1); bits |= __shfl_xor(bits, 2); bits |= __shfl_xor(bits, 4);
        if (part == 0) ((LAS unsigned*)(shm + L_SELM))[tk] = bits;
    }
    asm volatile("s_waitcnt lgkmcnt(0)\n\ts_barrier" ::: "memory");
    const unsigned selbits = ((const LAS unsigned*)(shm + L_SELM))[tq];
    float mhat = 0.f, l_reg = 0.f; f32x16 negm = f32x16{};
    o[0] = f32x16{}; o[1] = f32x16{};
    for (int i = 2; i < NT; ++i) {
        if (i + 1 < NT) { NSA_WAIT_BAR(2); } else { NSA_WAIT_BAR(0); }
        NSA_ISSUE(i + 2);
        const bool is_sel = (i < 3 + cur);
        const int j = is_sel ? (i - 2) : (wj0 + (i - 3 - cur));
        const bool first = (i == 2) || (i == 3 + cur);
        if (i == 3 + cur) {
            float lt = l_reg + xhalf(l_reg); NSA_ACCUM(gt1 / lt);
            mhat = 0.f; l_reg = 0.f; negm = f32x16{}; o[0] = f32x16{}; o[1] = f32x16{};
        }
        const LAS unsigned char* ks = kbase + (i & (NSLOT - 1)) * SLOTB;
        const LAS unsigned char* vs = vbase + (i & (NSLOT - 1)) * SLOTB;
        f32x16 ci = negm;
        if (is_sel) { const bool on = (selbits >> j) & 1u;
#pragma unroll
            for (int r = 0; r < 16; ++r) ci[r] = on ? negm[r] : -INFINITY; }
        f32x16 p0, p1;
        qkt(p0, p1, ks, qr, ci, r32, hi);
        if (j == cur) edge_mask<1>(p0, p1, tq, hi);
        else if (!is_sel && i == 3 + cur && cur >= 8) edge_mask<2>(p0, p1, tq, hi);
        float rm = rowmax32(p0, p1); rm = fmaxf(rm, xhalf(rm));
        bool resc = false;
        if (first) {
            const float dl = (rm > -INFINITY) ? rm : 0.f; mhat = dl;
#pragma unroll
            for (int r = 0; r < 16; ++r) { p0[r] -= dl; p1[r] -= dl; negm[r] = -mhat; }
        } else if (__any(rm > (float)THRL)) {
            const float dl = fmaxf(rm, 0.f); mhat += dl;
#pragma unroll
            for (int r = 0; r < 16; ++r) { p0[r] -= dl; p1[r] -= dl; negm[r] = -mhat; }
            const float f = __builtin_amdgcn_exp2f(-dl); l_reg *= f; if (hi == 0) wsf[r32] = f; resc = true;
        }
        float sacc = 0.f;
#pragma unroll
        for (int r = 0; r < 16; ++r) { p0[r] = __builtin_amdgcn_exp2f(p0[r]); p1[r] = __builtin_amdgcn_exp2f(p1[r]); sacc += p0[r] + p1[r]; }
        l_reg += sacc;
        if (resc) { asm volatile("s_waitcnt lgkmcnt(0)" ::: "memory");
#pragma unroll
            for (int r = 0; r < 16; ++r) { const float f_ = wsf[crow(r, hi)]; o[0][r] *= f_; o[1][r] *= f_; }
            asm volatile("s_waitcnt lgkmcnt(0)" ::: "memory"); }
        NSA_PACK(p0, p1);
        pv(o, vs, NSA_PAF(0), NSA_PAF(1), NSA_PAF(2), NSA_PAF(3));
    }
    { float lt = l_reg + xhalf(l_reg); NSA_ACCUM(gt2 / lt); }
    asm volatile("s_waitcnt lgkmcnt(0)\n\ts_barrier" ::: "memory");
    {
        LAS bf16* stg = (LAS bf16*)(shm + L_OST) + wid * 2048;
#pragma unroll
        for (int r = 0; r < 16; ++r) { const int orow = crow(r, hi);
#pragma unroll
            for (int d0 = 0; d0 < 2; ++d0) stg[orow * 64 + d0 * 32 + r32] = (bf16)f2bf(oc[d0][r]); }
        asm volatile("s_waitcnt lgkmcnt(0)" ::: "memory");
#pragma unroll
        for (int i = 0; i < 4; ++i) { const int row = i * 8 + (lane >> 3), ch = lane & 7;
            const u32x4 ov = *(const LAS u32x4*)(stg + row * 64 + ch * 8);
            const size_t grow = rowb + t0 + 32 * th + row;
            const u32x4 gv = *(const u32x4*)(T.proj + grow * NP + C_AG + hq * 64 + ch * 8);
            u32x4 res;
#pragma unroll
            for (int e = 0; e < 4; ++e) { const float o_lo = __uint_as_float(ov[e] << 16), o_hi = __uint_as_float(ov[e] & 0xffff0000u);
                const float g_lo = __uint_as_float(gv[e] << 16), g_hi = __uint_as_float(gv[e] & 0xffff0000u);
                res[e] = cvtpk(o_lo * siluf_(g_lo), o_hi * siluf_(g_hi)); }
            *(u32x4*)(T.mix + grow * DM + 512 + hq * 64 + ch * 8) = res; }
    }
    asm volatile("s_waitcnt vmcnt(0) lgkmcnt(0)\n\ts_barrier" ::: "memory");
#undef NSA_ISSUE
#undef NSA_PACK
#undef NSA_PAF
#undef NSA_ACCUM
}

__device__ __forceinline__ void nsa_phase(LAS unsigned char* lds, const Tensors& T, int vcu, int G) {
    for (int v = vcu; v < 256; v += G) {
        const int bg = v >> 3, s = v & 7;
#pragma unroll 1
        for (int i = 0; i < 4; ++i) { const int cur = (i == 0) ? s : (i == 1) ? 15 - s : (i == 2) ? 16 + s : 31 - s; nsa_unit<8>(bg >> 1, bg & 1, cur, T, lds); }
    }
}
#undef NSA_SBAR
#undef NSA_WAIT_BAR
}
namespace rnn {
using bf16x8 = __attribute__((ext_vector_type(8))) short;
using f32x16 = __attribute__((ext_vector_type(16))) float;
using f32x4v = __attribute__((ext_vector_type(4))) float;
using u32x4 = __attribute__((ext_vector_type(4))) unsigned;
using f32x2 = __attribute__((ext_vector_type(2))) float;
constexpr int CH = 128, NCHUNK = SEQ / CH;
constexpr int NITEMS = BATCH * 8 * NCHUNK;
constexpr int R_XS = 0;
constexpr int R_AS = 32768;
constexpr int R_XB = 65536;
constexpr int R_SM = R_XB + 128 * 144;
constexpr int R_END = R_SM + 2 * 8 * 64 * 4;
static_assert(R_END <= RING_BYTES, "rnn LDS map");
__device__ __forceinline__ int crow(int r, int hi) { return (r & 3) + 8 * (r >> 2) + 4 * hi; }

struct Params { const bf16* proj; const float* conv_w; const float* conv_b; const bf16* waT; const bf16* wxT; const float* ba; const float* bx; const float* lam; float* rsum; bf16* mix; };

template <int LEVEL>
__device__ __forceinline__ void rnn_item(int item, const Params& P, LAS unsigned char* shm) {
    const int tid = threadIdx.x, lane = tid & 63, r32 = lane & 31, hi = lane >> 5;
    const int wid = __builtin_amdgcn_readfirstlane(tid >> 6);
    const int ck = item % NCHUNK, h = (item / NCHUNK) & 7, b = item / (NCHUNK * 8);
    const int tc0 = ck * CH; const size_t rowb = (size_t)b * SEQ;
    LAS float* xs = (LAS float*)(shm + R_XS); LAS float* as = (LAS float*)(shm + R_AS); LAS unsigned char* xb = shm + R_XB; LAS float* sm = (LAS float*)(shm + R_SM);
    {
        const int tt = tid >> 3, cg = tid & 7; const int c0 = h * 64 + 8 * cg;
        float w[4][8], bias[8];
#pragma unroll
        for (int k = 0; k < 4; ++k) { const f32x4v w0 = *(const f32x4v*)(P.conv_w + k * 512 + c0), w1 = *(const f32x4v*)(P.conv_w + k * 512 + c0 + 4);
            w[k][0] = w0[0]; w[k][1] = w0[1]; w[k][2] = w0[2]; w[k][3] = w0[3]; w[k][4] = w1[0]; w[k][5] = w1[1]; w[k][6] = w1[2]; w[k][7] = w1[3]; }
        { const f32x4v b0 = *(const f32x4v*)(P.conv_b + c0), b1 = *(const f32x4v*)(P.conv_b + c0 + 4);
          bias[0] = b0[0]; bias[1] = b0[1]; bias[2] = b0[2]; bias[3] = b0[3]; bias[4] = b1[0]; bias[5] = b1[1]; bias[6] = b1[2]; bias[7] = b1[3]; }
#pragma unroll
        for (int half = 0; half < 2; ++half) {
            const int tk = tt + 64 * half, t = tc0 + tk;
            float acc[8];
#pragma unroll
            for (int e = 0; e < 8; ++e) acc[e] = bias[e];
#pragma unroll
            for (int k = 0; k < 4; ++k) { const int ts = t - 3 + k;
                u32x4 v = {0u, 0u, 0u, 0u};
                if (ts >= 0) v = *(const u32x4*)(P.proj + (rowb + ts) * NP + C_RX + c0);
#pragma unroll
                for (int e = 0; e < 4; ++e) { acc[2 * e] += w[k][2 * e] * __uint_as_float(v[e] << 16); acc[2 * e + 1] += w[k][2 * e + 1] * __uint_as_float(v[e] & 0xffff0000u); } }
            *(LAS f32x4v*)(xs + tk * 64 + 8 * cg) = (f32x4v){acc[0], acc[1], acc[2], acc[3]};
            *(LAS f32x4v*)(xs + tk * 64 + 8 * cg + 4) = (f32x4v){acc[4], acc[5], acc[6], acc[7]};
            u32x4 pk; pk.x = pk2(acc[0], acc[1]); pk.y = pk2(acc[2], acc[3]); pk.z = pk2(acc[4], acc[5]); pk.w = pk2(acc[6], acc[7]);
            *(LAS u32x4*)(xb + tk * 144 + cg * 16) = pk;
        }
    }
    __syncthreads();
    {
        const int tt = wid >> 1, jt = wid & 1; const int j = 32 * jt + r32;
        f32x16 ga = f32x16{}, gx = f32x16{};
        const bf16* wa = P.waT + h * 4096 + j * 64 + 8 * hi; const bf16* wx = P.wxT + h * 4096 + j * 64 + 8 * hi;
        const LAS unsigned char* xa = xb + (32 * tt + r32) * 144 + 16 * hi;
#pragma unroll
        for (int kk = 0; kk < 4; ++kk) {
            const bf16x8 af = *(const LAS bf16x8*)(xa + 32 * kk);
            const bf16x8 b1 = *(const bf16x8*)(wa + 16 * kk), b2 = *(const bf16x8*)(wx + 16 * kk);
            ga = __builtin_amdgcn_mfma_f32_32x32x16_bf16(af, b1, ga, 0, 0, 0);
            gx = __builtin_amdgcn_mfma_f32_32x32x16_bf16(af, b2, gx, 0, 0, 0);
        }
        const int c = h * 64 + j;
        const float bav = P.ba[c], bxv = P.bx[c], L = P.lam[c];
        const float ls8 = -8.0f * log1pf(__expf(-L));
#pragma unroll
        for (int r = 0; r < 16; ++r) { const int tk = 32 * tt + crow(r, hi);
            const float rg = sigmoidf_(ga[r] + bav), ig = sigmoidf_(gx[r] + bxv);
            const float log_a = ls8 * rg;
            const float a = __expf(log_a);
            const float x = xs[tk * 64 + j];
            const float u = sqrtf(fmaxf(1.0f - a * a, 0.f)) * (ig * x);
            as[tk * 64 + j] = a; xs[tk * 64 + j] = u; }
    }
    __syncthreads();
    {
        const int c = tid & 63, sc = tid >> 6;
        float A = 1.f, H = 0.f;
#pragma unroll
        for (int k = 0; k < 16; ++k) { const float a = as[(16 * sc + k) * 64 + c], u = xs[(16 * sc + k) * 64 + c]; H = fmaf(a, H, u); A *= a; }
        sm[sc * 64 + c] = A; sm[512 + sc * 64 + c] = H;
        if (LEVEL == 1) {
            __syncthreads();
            if (sc == 0) { float Ac = 1.f, Hc = 0.f;
#pragma unroll
                for (int s = 0; s < 8; ++s) { const float a_ = sm[s * 64 + c], h_ = sm[512 + s * 64 + c]; Hc = fmaf(a_, Hc, h_); Ac *= a_; }
                f32x2 o; o.x = Ac; o.y = Hc; *(f32x2*)(P.rsum + ((size_t)(b * NCHUNK + ck) * 512 + h * 64 + c) * 2) = o; }
        } else {
            float gv[16];
#pragma unroll
            for (int k = 0; k < 16; ++k) gv[k] = bf2f(P.proj[(rowb + tc0 + 16 * sc + k) * NP + C_RG + h * 64 + c]);
            float Hs = 0.f;
#pragma unroll
            for (int q = 0; q < NCHUNK - 1; ++q) { if (q < ck) { const f32x2 s2 = *(const f32x2*)(P.rsum + ((size_t)(b * NCHUNK + q) * 512 + h * 64 + c) * 2); Hs = fmaf(s2.x, Hs, s2.y); } }
            __syncthreads();
#pragma unroll
            for (int s = 0; s < 7; ++s) { if (s < sc) Hs = fmaf(sm[s * 64 + c], Hs, sm[512 + s * 64 + c]); }
            float hcur = Hs;
#pragma unroll
            for (int k = 0; k < 16; ++k) { const int tk = 16 * sc + k; const float a = as[tk * 64 + c], u = xs[tk * 64 + c]; hcur = fmaf(a, hcur, u);
                P.mix[(rowb + tc0 + tk) * DM + h * 64 + c] = (bf16)f2bf(hcur * siluf_(gv[k])); }
        }
    }
    __syncthreads();
}
}

namespace cmpr {
using bf16x8 = __attribute__((ext_vector_type(8))) short;
using f32x4v = __attribute__((ext_vector_type(4))) float;
using u32x2 = __attribute__((ext_vector_type(2))) unsigned;
constexpr int NUNITS = 2 * 64;
constexpr int HPITCH = 528;
struct Params { const bf16* proj; const bf16* w1k; const bf16* w1v; const bf16* w2k; const bf16* w2v; const float* bias1; bf16* outk; bf16* outv; };
__device__ __forceinline__ void cmp_unit(int unit, const Params& P, LAS unsigned char* shm) {
    const int tid = threadIdx.x, lane = tid & 63, fr = lane & 15, fq = lane >> 4;
    const int wid = __builtin_amdgcn_readfirstlane(tid >> 6);
    const int mt = unit >> 6, rt = unit & 63;
    const int ccol = mt ? C_VC : C_KC;
    const int bg = rt >> 1, cb = 64 * (rt & 1) + fr;
    const bf16* a0 = P.proj + ((size_t)(bg >> 1) * SEQ + 16 * cb) * NP + ccol + (bg & 1) * 64 + 8 * fq;
    const bf16* a3 = a0 + (size_t)((cb + 48 < NC ? 768 : 752)) * NP;
    const bf16* b0p = (mt ? P.w1v : P.w1k) + (size_t)(32 * wid + fr) * 2048 + 8 * fq;
    f32x4v acc00 = {0.f, 0.f, 0.f, 0.f}, acc01 = acc00, acc10 = acc00, acc11 = acc00, acc20 = acc00, acc21 = acc00, acc30 = acc00, acc31 = acc00;
#pragma unroll 2
    for (int kk = 0; kk < 64; ++kk) {
        const size_t aoff = (size_t)(kk >> 1) * NP + 32 * (kk & 1);
        const bf16x8 af0 = *(const bf16x8*)(a0 + aoff), af1 = *(const bf16x8*)(a0 + aoff + (size_t)256 * NP), af2 = *(const bf16x8*)(a0 + aoff + (size_t)512 * NP), af3 = *(const bf16x8*)(a3 + aoff);
        const bf16x8 bf0 = *(const bf16x8*)(b0p + 32 * kk), bf1 = *(const bf16x8*)(b0p + 32 * kk + 16 * 2048);
        acc00 = __builtin_amdgcn_mfma_f32_16x16x32_bf16(bf0, af0, acc00, 0, 0, 0); acc01 = __builtin_amdgcn_mfma_f32_16x16x32_bf16(bf1, af0, acc01, 0, 0, 0);
        acc10 = __builtin_amdgcn_mfma_f32_16x16x32_bf16(bf0, af1, acc10, 0, 0, 0); acc11 = __builtin_amdgcn_mfma_f32_16x16x32_bf16(bf1, af1, acc11, 0, 0, 0);
        acc20 = __builtin_amdgcn_mfma_f32_16x16x32_bf16(bf0, af2, acc20, 0, 0, 0); acc21 = __builtin_amdgcn_mfma_f32_16x16x32_bf16(bf1, af2, acc21, 0, 0, 0);
        acc30 = __builtin_amdgcn_mfma_f32_16x16x32_bf16(bf0, af3, acc30, 0, 0, 0); acc31 = __builtin_amdgcn_mfma_f32_16x16x32_bf16(bf1, af3, acc31, 0, 0, 0);
    }
#define CMP_PUT(ACC, mi, ni) do { const int n0_ = 32 * wid + 16 * (ni) + 4 * fq; const f32x4v v_ = ACC + *(const f32x4v*)(P.bias1 + mt * 256 + n0_); u32x2 w_; \
        w_.x = pk2(siluf_(v_[0]), siluf_(v_[1])); w_.y = pk2(siluf_(v_[2]), siluf_(v_[3])); *(LAS u32x2*)(shm + (16 * (mi) + fr) * HPITCH + n0_ * 2) = w_; } while (0)
    CMP_PUT(acc00, 0, 0); CMP_PUT(acc01, 0, 1); CMP_PUT(acc10, 1, 0); CMP_PUT(acc11, 1, 1); CMP_PUT(acc20, 2, 0); CMP_PUT(acc21, 2, 1); CMP_PUT(acc30, 3, 0); CMP_PUT(acc31, 3, 1);
#undef CMP_PUT
    __syncthreads();
    {
        const int mi2 = wid >> 1; f32x4v o20 = {0.f, 0.f, 0.f, 0.f}, o21 = o20;
        const LAS unsigned char* hrow = shm + (16 * mi2 + fr) * HPITCH + 16 * fq;
        const bf16* w2p = (mt ? P.w2v : P.w2k) + (size_t)(32 * (wid & 1) + fr) * 256 + 8 * fq;
#pragma unroll
        for (int kk = 0; kk < 8; ++kk) { const bf16x8 hf = *(const LAS bf16x8*)(hrow + 64 * kk);
            const bf16x8 wf0 = *(const bf16x8*)(w2p + 32 * kk), wf1 = *(const bf16x8*)(w2p + 32 * kk + 16 * 256);
            o20 = __builtin_amdgcn_mfma_f32_16x16x32_bf16(wf0, hf, o20, 0, 0, 0); o21 = __builtin_amdgcn_mfma_f32_16x16x32_bf16(wf1, hf, o21, 0, 0, 0); }
        const int m = 64 * rt + 16 * mi2 + fr; const bool padrow = (m & 127) == 127;
        { u32x2 w; w.x = pk2(o20[0], o20[1]); w.y = pk2(o20[2], o20[3]); if (padrow) { w.x = 0u; w.y = 0u; } *(u32x2*)((mt ? P.outv : P.outk) + (size_t)m * 64 + 32 * (wid & 1) + 4 * fq) = w; }
        { u32x2 w; w.x = pk2(o21[0], o21[1]); w.y = pk2(o21[2], o21[3]); if (padrow) { w.x = 0u; w.y = 0u; } *(u32x2*)((mt ? P.outv : P.outk) + (size_t)m * 64 + 32 * (wid & 1) + 16 + 4 * fq) = w; }
    }
    __syncthreads();
}
}
struct Frame {
    LAS unsigned char* lds;
    volatile LAS unsigned* MISC;
    gu32* ctl;
    int tid, lane, wave, vcu, G;
};

__device__ __forceinline__ void p0_transpose_item(const float* W, int K, int Nsrc, bf16* WT, LAS float* scr, int kb, int nb, int lane) {
    const int k0 = 64 * kb, n0 = 32 * nb; const int nn = n0 + (lane & 31); const bool ok = nn < Nsrc;
#pragma unroll 8
    for (int i = 0; i < 32; ++i) { const int kk = 2 * i + (lane >> 5); scr[kk * 33 + (lane & 31)] = ok ? W[(size_t)(k0 + kk) * Nsrc + nn] : 0.f; }
    LDS_WAIT(); asm volatile("" ::: "memory");
    const int c = lane & 7;
#pragma unroll
    for (int j = 0; j < 4; ++j) { const int n = (lane >> 3) + 8 * j; const LAS float* s = scr + (8 * c) * 33 + n;
        v4u o; o.x = pk2(s[0 * 33], s[1 * 33]); o.y = pk2(s[2 * 33], s[3 * 33]); o.z = pk2(s[4 * 33], s[5 * 33]); o.w = pk2(s[6 * 33], s[7 * 33]);
        *(GAS v4u*)(WT + (size_t)(n0 + n) * K + k0 + 8 * c) = o; }
    LDS_WAIT(); asm volatile("" ::: "memory");
}
__device__ __forceinline__ void rms_row_to_bf16(const float* xrow, const float* w, bf16* orow, int lane) {
    const GAS f32x4* xr = (const GAS f32x4*)xrow + lane; const GAS f32x4* wr = (const GAS f32x4*)w + lane;
    f32x4 v[4]; float s = 0.f;
#pragma unroll
    for (int j = 0; j < 4; ++j) { v[j] = xr[64 * j]; s += (v[j].x * v[j].x + v[j].y * v[j].y) + (v[j].z * v[j].z + v[j].w * v[j].w); }
    const float rstd = rsqrtf(wave_sum(s) * (1.f / DM) + EPS);
    GAS unsigned long long* o8 = (GAS unsigned long long*)orow + lane;
#pragma unroll
    for (int j = 0; j < 4; ++j) { const f32x4 ww = wr[64 * j]; o8[64 * j] = (unsigned long long)pk2(v[j].x * rstd * ww.x, v[j].y * rstd * ww.y) | ((unsigned long long)pk2(v[j].z * rstd * ww.z, v[j].w * rstd * ww.w) << 32); }
}

struct Args { const float* in[18]; float* out; unsigned char* ws; int ph_lo, ph_hi, li, pad; };

__device__ __forceinline__ void p0_prologue(Frame& F, const Args& args) {
    LAS float* scr = (LAS float*)(F.lds + RING_OFF + F.wave * 16384);
    unsigned char* ws = args.ws;
    const int gw = F.vcu * NWAVES + F.wave, NGW = F.G * NWAVES;
    constexpr int I_IN = (DM / 64) * (NP / 32);
    constexpr int I_O = (DM / 64) * (DM / 32);
    constexpr int I_1 = (2048 / 64) * (256 / 32);
    constexpr int I_2 = (256 / 64) * (64 / 32);
    constexpr int I_G = 8 * 2;
    constexpr int I_B = 2 * 32;
    constexpr int NITEMS = I_IN + I_O + 2 * I_1 + 2 * I_2 + 2 * I_G + I_B;
    for (int it = gw; it < NITEMS; it += NGW) {
        int r = it;
        if (r < I_IN) { p0_transpose_item(args.in[2], DM, DIN, (bf16*)(ws + WS_WIN), scr, r / (NP / 32), r % (NP / 32), F.lane); continue; } r -= I_IN;
        if (r < I_O) { p0_transpose_item(args.in[16], DM, DM, (bf16*)(ws + WS_WO), scr, r / (DM / 32), r % (DM / 32), F.lane); continue; } r -= I_O;
        if (r < I_1) { p0_transpose_item(args.in[11], 2048, 256, (bf16*)(ws + WS_W1K), scr, r / 8, r % 8, F.lane); continue; } r -= I_1;
        if (r < I_1) { p0_transpose_item(args.in[14], 2048, 256, (bf16*)(ws + WS_W1V), scr, r / 8, r % 8, F.lane); continue; } r -= I_1;
        if (r < I_2) { p0_transpose_item(args.in[12], 256, 64, (bf16*)(ws + WS_W2K), scr, r / 2, r % 2, F.lane); continue; } r -= I_2;
        if (r < I_2) { p0_transpose_item(args.in[15], 256, 64, (bf16*)(ws + WS_W2V), scr, r / 2, r % 2, F.lane); continue; } r -= I_2;
        if (r < I_G) { const int h = r >> 1; p0_transpose_item(args.in[5] + h * 4096, 64, 64, (bf16*)(ws + WS_WA) + h * 4096, scr, 0, r & 1, F.lane); continue; } r -= I_G;
        if (r < I_G) { const int h = r >> 1; p0_transpose_item(args.in[7] + h * 4096, 64, 64, (bf16*)(ws + WS_WX) + h * 4096, scr, 0, r & 1, F.lane); continue; } r -= I_G;
        {
            const int mt = r >> 5, kc = r & 31; const float* pe = args.in[mt ? 13 : 10] + kc * 64; const float* w1 = args.in[mt ? 14 : 11] + (size_t)kc * 64 * 256;
            f32x4 a = {0.f, 0.f, 0.f, 0.f};
#pragma unroll 8
            for (int k = 0; k < 64; ++k) { const float p = pe[k]; const f32x4 w = *(const GAS f32x4*)(w1 + (size_t)k * 256 + 4 * F.lane); a += w * p; }
            *(GAS f32x4*)((float*)(ws + WS_B1P) + (size_t)(mt * 32 + kc) * 256 + 4 * F.lane) = a;
        }
    }
    for (int m = gw; m < M; m += NGW) rms_row_to_bf16(args.in[0] + (size_t)m * DM, args.in[1], (bf16*)(ws + WS_XN) + (size_t)m * DM, F.lane);
}

__device__ __forceinline__ void p5_final_norm(Frame& F, const Args& args) {
    const int gw = F.vcu * NWAVES + F.wave, NGW = F.G * NWAVES;
    const float* ssq = (const float*)(args.ws + WS_SSQ); const GAS f32x4* wr = (const GAS f32x4*)args.in[17] + F.lane;
    for (int m = gw; m < M; m += NGW) {
        float s = (F.lane < 16) ? ssq[(size_t)m * 16 + F.lane] : 0.f;
        s += __shfl_xor(s, 1); s += __shfl_xor(s, 2); s += __shfl_xor(s, 4); s += __shfl_xor(s, 8);
        s = __shfl(s, 0);
        const float rstd = rsqrtf(s * (1.f / DM) + EPS);
        GAS f32x4* yr = (GAS f32x4*)(args.out + (size_t)m * DM) + F.lane;
#pragma unroll
        for (int j = 0; j < 4; ++j) { f32x4 v = yr[64 * j]; const f32x4 ww = wr[64 * j]; v = v * rstd * ww; yr[64 * j] = v; }
    }
}

__global__ void __launch_bounds__(NWAVES * 64, 2) mk_fwd(Args args) {
    extern __shared__ __attribute__((aligned(16))) unsigned char lds[];
    Frame F;
    F.lds = (LAS unsigned char*)lds;
    F.MISC = (volatile LAS unsigned*)(F.lds + MISC_OFF);
    F.tid = threadIdx.x; F.lane = F.tid & 63; F.wave = __builtin_amdgcn_readfirstlane(F.tid >> 6);
    F.G = gridDim.x; { const int bx = blockIdx.x; F.vcu = (F.G % 8 == 0) ? (bx % 8) * (F.G / 8) + bx / 8 : bx; }
    unsigned char* ws = args.ws;
    F.ctl = (gu32*)(ws + WS_CTL);
    for (int u = F.tid; u < (LDS_BYTES - LDSCTL_OFF) / 4; u += NWAVES * 64) ((LAS unsigned*)(F.lds + LDSCTL_OFF))[u] = 0u;
    __syncthreads();
    XcdBarrier bar = xcd_barrier_post((unsigned*)(F.ctl + CW_BAR) + args.li * XCD_BAR_WORDS, F.MISC + 8);
    const int lo = args.ph_lo, hi = args.ph_hi;
#define IN(k) (lo <= (k) && (k) < hi)
#define BOTH(k) (IN(k) && IN((k) + 1))
    if (IN(0)) { p0_prologue(F, args); if (BOTH(0)) xcd_barrier(bar); }
    if (IN(1)) {
        if (blockIdx.x == 0) {
            const float* part = (const float*)(ws + WS_B1P); const int mt = F.tid >> 8, n = F.tid & 255; float s = 0.f;
            for (int kc = 0; kc < 32; ++kc) s += part[(size_t)(mt * 32 + kc) * 256 + n];
            ((float*)(ws + WS_B1))[F.tid] = s;
        }
        pg8::Gemm g{(const bf16*)(ws + WS_XN), (const bf16*)(ws + WS_WIN), M, NP, DM}; pg8::StaticOrder S; S.init(M, NP, F.G, (int)blockIdx.x);
        pg8::EpiProj E{(bf16*)(ws + WS_PROJ), NP, QSCALE};
        pg8::gemm_phase<pg8::EpiProj, pg8::StaticOrder, true, true>(F.lds + RING_OFF, g, S, E);
        if (BOTH(1)) xcd_barrier(bar);
    }
    if (IN(2)) {
        cmpr::Params CP{(const bf16*)(ws + WS_PROJ), (const bf16*)(ws + WS_W1K), (const bf16*)(ws + WS_W1V), (const bf16*)(ws + WS_W2K), (const bf16*)(ws + WS_W2V), (const float*)(ws + WS_B1), (bf16*)(ws + WS_KC), (bf16*)(ws + WS_VC)};
        for (int u = F.vcu; u < 2 * cmpr::NUNITS; u += F.G) if (!(u & 1)) cmpr::cmp_unit(u >> 1, CP, F.lds + RING_OFF);
        rnn::Params RP{(const bf16*)(ws + WS_PROJ), args.in[3], args.in[4], (const bf16*)(ws + WS_WA), (const bf16*)(ws + WS_WX), args.in[6], args.in[8], args.in[9], (float*)(ws + WS_RSUM), (bf16*)(ws + WS_MIX)};
        for (int it = F.vcu; it < rnn::NITEMS; it += F.G) rnn::rnn_item<1>(it, RP, F.lds + RING_OFF);
        if (BOTH(2)) xcd_barrier(bar);
    }
    if (IN(3)) {
        nsa::Tensors T{(const bf16*)(ws + WS_PROJ), (const bf16*)(ws + WS_KC), (const bf16*)(ws + WS_VC), (bf16*)(ws + WS_MIX)};
        nsa::nsa_phase(F.lds + RING_OFF, T, F.vcu, F.G);
        rnn::Params RP{(const bf16*)(ws + WS_PROJ), args.in[3], args.in[4], (const bf16*)(ws + WS_WA), (const bf16*)(ws + WS_WX), args.in[6], args.in[8], args.in[9], (float*)(ws + WS_RSUM), (bf16*)(ws + WS_MIX)};
        for (int it = F.vcu; it < rnn::NITEMS; it += F.G) rnn::rnn_item<2>(it, RP, F.lds + RING_OFF);
        if (BOTH(3)) xcd_barrier(bar);
    }
    if (IN(4)) {
        pg8::Gemm g{(const bf16*)(ws + WS_MIX), (const bf16*)(ws + WS_WO), M, DM, DM}; pg8::StaticOrder S; S.init(M, DM, F.G, (int)blockIdx.x);
        pg8::EpiResid E{args.in[0], args.out, (float*)(ws + WS_SSQ), DM};
        pg8::gemm_phase<pg8::EpiResid, pg8::StaticOrder, true, true>(F.lds + RING_OFF, g, S, E);
        if (BOTH(4)) xcd_barrier(bar);
    }
    if (IN(5)) { p5_final_norm(F, args); }
#undef IN
#undef BOTH
}
extern "C" void kernel_launch(void* const* d_in, const int* in_sizes, int n_in, void* d_out, int out_size, void* d_ws, size_t ws_size, hipStream_t stream) {
    static int grid = 0;
    if (grid == 0) {
        if (n_in != 18 || in_sizes[0] != M * DM || out_size != M * DM || ws_size < WS_END) { fprintf(stderr, "kernel_launch: unexpected shapes (n_in %d, in0 %d, out %d, ws %zu); nothing launched\n", n_in, n_in > 0 ? in_sizes[0] : -1, out_size, ws_size); grid = -1; return; }
        int dev = 0, cus = 0;
        if (hipGetDevice(&dev) != hipSuccess || hipDeviceGetAttribute(&cus, hipDeviceAttributeMultiprocessorCount, dev) != hipSuccess) { grid = -1; return; }
        if (hipFuncSetAttribute((const void*)mk_fwd, hipFuncAttributeMaxDynamicSharedMemorySize, LDS_BYTES) != hipSuccess) { fprintf(stderr, "kernel_launch: hipFuncSetAttribute failed\n"); grid = -1; return; }
        (void)hipGetLastError();
        grid = cus;
    }
    if (grid < 0) return;
    (void)hipMemsetAsync((char*)d_ws + WS_CTL, 0, CTL_ZERO_BYTES, stream);
    Args a{};
    for (int i = 0; i < 18; ++i) a.in[i] = (const float*)d_in[i];
    a.out = (float*)d_out; a.ws = (unsigned char*)d_ws;
    unsigned char* ws = (unsigned char*)d_ws;
    a.ph_lo = 0; a.ph_hi = 6; a.li = 0;
    hipLaunchKernelGGL(mk_fwd, dim3(grid), dim3(NWAVES * 64), LDS_BYTES, stream, a);
}
```
